# Optimizing an MI355X kernel written in HIP

```python
import jax, jax.numpy as jnp
from jax import lax
import numpy as np

D_MODEL = 2048
BATCH = 2
SEQ = 16384
DEPTH = 2

A_HEAD_DIM = 128
A_WIDTH = D_MODEL // 2
A_HEADS = A_WIDTH // A_HEAD_DIM
CHUNK = 64
F_MIN = 1e-6
NA_HEAD_DIM = 128
NA_WIDTH = D_MODEL // 2
NA_HEADS = NA_WIDTH // NA_HEAD_DIM
GRID_W = 64
WIN_R_MAX = 8
WIN_C = 16
FFN_HIDDEN = -(-(8 * D_MODEL) // (3 * 256)) * 256
PLE_DIM = 256
DEEPNORM_ALPHA = (2 * DEPTH) ** 0.25
DEEPNORM_BETA = (8 * DEPTH) ** -0.25
LN_EPS = 1e-5
RMS_EPS = 1e-6
SPLIT_SIZES = (A_WIDTH,) * 5 + (NA_WIDTH,) * 3 + (D_MODEL, D_MODEL)
N_IN = sum(SPLIT_SIZES)

kernel_name = "hgrn2_natten2d_gated_hybrid_deepnorm"


def layer_norm(x, g, b):
    xf = x.astype(jnp.float32)
    mu = jnp.mean(xf, axis=-1, keepdims=True)
    xc = xf - mu
    var = jnp.mean(xc * xc, axis=-1, keepdims=True)
    y = xc * lax.rsqrt(var + LN_EPS) * g.astype(jnp.float32) + b.astype(jnp.float32)
    return y.astype(x.dtype)


def gla_chunked(q, k, v, logf):
    B_, S_, H, Dh = q.shape
    n = S_ // CHUNK

    def to_chunks(a):
        return a.reshape(B_, n, CHUNK, H, Dh).transpose(1, 0, 3, 2, 4)

    qc, kc, vc, gc = to_chunks(q), to_chunks(k), to_chunks(v), to_chunks(logf)
    gc = jnp.cumsum(gc, axis=3)
    causal_in_chunk = jnp.tril(jnp.ones((CHUNK, CHUNK), dtype=bool))[:, :, None]

    def step(state, inp):
        qb, kb, vb, gb = inp
        o_inter = jnp.einsum('bhtk,bhkv->bhtv', qb * jnp.exp(gb), state)
        diff = gb[:, :, :, None, :] - gb[:, :, None, :, :]
        decay = jnp.where(causal_in_chunk, jnp.exp(jnp.where(causal_in_chunk, diff, 0.0)), 0.0)
        att = jnp.einsum('bhtk,bhsk,bhtsk->bhts', qb, kb, decay)
        o = o_inter + jnp.einsum('bhts,bhsv->bhtv', att, vb)
        g_last = gb[:, :, -1, :]
        k_dec = kb * jnp.exp(g_last[:, :, None, :] - gb)
        state = state * jnp.exp(g_last)[..., None] + jnp.einsum('bhsk,bhsv->bhkv', k_dec, vb)
        return state, o

    state0 = jnp.zeros((B_, H, Dh, Dh), jnp.float32)
    _, o = lax.scan(step, state0, (qc, kc, vc, gc))
    return o.transpose(1, 0, 3, 2, 4).reshape(B_, S_, H, Dh)


def hgrn2_mixer(q_raw, i_raw, g_raw, f_fw_raw, f_bw_raw, lb, norm_g):
    B_, S_, _ = q_raw.shape

    def heads(a):
        return a.astype(jnp.float32).reshape(B_, S_, A_HEADS, A_HEAD_DIM)

    q = heads(jax.nn.silu(q_raw.astype(jnp.float32)))
    v = heads(i_raw)
    lb = lb.astype(jnp.float32)

    def forget(f_raw, lb_dir):
        f = lb_dir + (1.0 - lb_dir) * jax.nn.sigmoid(f_raw.astype(jnp.float32))
        f = jnp.clip(f, F_MIN, 1.0)
        return heads(f)

    f_fw = forget(f_fw_raw, lb[0])
    f_bw = forget(f_bw_raw, lb[1])
    o_fw = gla_chunked(q, 1.0 - f_fw, v, jnp.log(f_fw))
    flip = lambda a: jnp.flip(a, axis=1)
    o_bw = flip(gla_chunked(flip(q), flip(1.0 - f_bw), flip(v), flip(jnp.log(f_bw))))
    o = o_fw + o_bw
    o = o * lax.rsqrt(jnp.mean(o * o, axis=-1, keepdims=True) + RMS_EPS)
    o = o.reshape(B_, S_, A_WIDTH) * norm_g.astype(jnp.float32) * jax.nn.silu(g_raw.astype(jnp.float32))
    return o.astype(q_raw.dtype)


def neighbourhood_attention(q, k, v, rpb):
    B_, S_, _ = q.shape
    rows = S_ // GRID_W
    wr = min(WIN_R_MAX, rows)

    def grid(a):
        return a.astype(jnp.float32).reshape(B_, rows, GRID_W, NA_HEADS, NA_HEAD_DIM)

    qg, kg, vg = grid(q), grid(k), grid(v)
    col = jnp.arange(GRID_W)
    col_start = jnp.clip(col - WIN_C // 2, 0, GRID_W - WIN_C)
    col_idx = col_start[:, None] + jnp.arange(WIN_C)[None, :]
    dc = col_idx - col[:, None]
    rpb_c = rpb.astype(jnp.float32)[:, :, dc + WIN_C - 1]
    scale = NA_HEAD_DIM ** -0.5

    def row_block(r):
        rs = jnp.clip(r - WIN_R_MAX // 2, 0, rows - wr)
        k_rows = lax.dynamic_slice_in_dim(kg, rs, wr, axis=1)
        v_rows = lax.dynamic_slice_in_dim(vg, rs, wr, axis=1)
        k_win = k_rows[:, :, col_idx]
        v_win = v_rows[:, :, col_idx]
        q_row = lax.dynamic_index_in_dim(qg, r, axis=1, keepdims=False)
        dr = rs + jnp.arange(wr) - r
        bias = rpb_c[:, dr + WIN_R_MAX - 1].transpose(0, 2, 1, 3)
        s = jnp.einsum('bchd,brcjhd->bhcrj', q_row, k_win) * scale + bias[None]
        prob = jax.nn.softmax(s.reshape(B_, NA_HEADS, GRID_W, wr * WIN_C), axis=-1)
        prob = prob.reshape(B_, NA_HEADS, GRID_W, wr, WIN_C)
        return jnp.einsum('bhcrj,brcjhd->bchd', prob, v_win)

    out = lax.map(row_block, jnp.arange(rows))
    return out.transpose(1, 0, 2, 3, 4).reshape(B_, S_, NA_WIDTH).astype(q.dtype)


def setup_inputs(seed: int = 0) -> dict:
    key = jax.random.key(seed)
    ks = jax.random.split(key, 17)

    def nrm(k, shape, scale):
        return jax.random.normal(k, shape, jnp.float32) * scale

    return {
        "x": nrm(ks[0], (BATCH, SEQ, D_MODEL), 1.0),
        "p": nrm(ks[1], (DEPTH, BATCH, SEQ, PLE_DIM), 1.0),
        "w_in": nrm(ks[2], (DEPTH, D_MODEL, N_IN), D_MODEL ** -0.5),
        "b_in": nrm(ks[3], (DEPTH, N_IN), 0.02),
        "lb_logits": nrm(ks[4], (DEPTH, 2, A_WIDTH), 1.0),
        "a_norm_g": 1.0 + nrm(ks[5], (DEPTH, A_WIDTH), 0.01),
        "rpb": nrm(ks[6], (DEPTH, NA_HEADS, 2 * WIN_R_MAX - 1, 2 * WIN_C - 1), 0.02),
        "w_branch": nrm(ks[7], (DEPTH, 2, A_WIDTH, D_MODEL), A_WIDTH ** -0.5),
        "w_out": nrm(ks[8], (DEPTH, D_MODEL, D_MODEL), DEEPNORM_BETA * D_MODEL ** -0.5),
        "ln1_g": 1.0 + nrm(ks[9], (DEPTH, D_MODEL), 0.01),
        "ln1_b": nrm(ks[10], (DEPTH, D_MODEL), 0.01),
        "w_ffn_up": nrm(ks[11], (DEPTH, D_MODEL, 2 * FFN_HIDDEN), D_MODEL ** -0.5),
        "w_ffn_down": nrm(ks[12], (DEPTH, FFN_HIDDEN, D_MODEL), DEEPNORM_BETA * FFN_HIDDEN ** -0.5),
        "w_pe": nrm(ks[13], (DEPTH, PLE_DIM, D_MODEL), DEEPNORM_BETA * PLE_DIM ** -0.5),
        "w_pg": nrm(ks[14], (DEPTH, D_MODEL, D_MODEL), D_MODEL ** -0.5),
        "ln2_g": 1.0 + nrm(ks[15], (DEPTH, D_MODEL), 0.01),
        "ln2_b": nrm(ks[16], (DEPTH, D_MODEL), 0.01),
    }


def reference(x, p, w_in, b_in, lb_logits, a_norm_g, rpb, w_branch, w_out, ln1_g, ln1_b,
              w_ffn_up, w_ffn_down, w_pe, w_pg, ln2_g, ln2_b):
    split_points = [int(c) for c in np.cumsum(SPLIT_SIZES)[:-1]]
    lb_sm = jax.nn.softmax(lb_logits.astype(jnp.float32), axis=0)
    lower_bounds = jnp.cumsum(lb_sm, axis=0) - lb_sm[0:1]

    for l in range(DEPTH):
        proj = jnp.einsum('bsd,de->bse', x, w_in[l]) + b_in[l]
        qa, ia, ga, f_fw, f_bw, qb, kb, vb, gate_a, gate_b = jnp.split(proj, split_points, axis=-1)
        oa = hgrn2_mixer(qa, ia, ga, f_fw, f_bw, lower_bounds[l], a_norm_g[l])
        ob = neighbourhood_attention(qb, kb, vb, rpb[l])
        merged = (jax.nn.sigmoid(gate_a) * jnp.einsum('bse,ed->bsd', oa, w_branch[l, 0])
                  + jax.nn.sigmoid(gate_b) * jnp.einsum('bse,ed->bsd', ob, w_branch[l, 1]))
        mix = jnp.einsum('bsd,de->bse', merged, w_out[l])
        x = layer_norm(DEEPNORM_ALPHA * x + mix, ln1_g[l], ln1_b[l])
        up = jnp.einsum('bsd,df->bsf', x, w_ffn_up[l])
        u_gate, u_val = jnp.split(up, 2, axis=-1)
        ffn = jnp.einsum('bsf,fd->bsd', jax.nn.silu(u_gate) * u_val, w_ffn_down[l])
        ple = jax.nn.sigmoid(jnp.einsum('bsd,de->bse', x, w_pg[l])) * jnp.einsum('bsk,kd->bsd', p[l], w_pe[l])
        x = layer_norm(DEEPNORM_ALPHA * x + ffn + ple, ln2_g[l], ln2_b[l])
    return x
```

```cpp
#include <hip/hip_runtime.h>
#include <hip/hip_cooperative_groups.h>
#include <cstdio>
namespace cg = cooperative_groups;

#define LAS __attribute__((address_space(3)))
typedef unsigned short u16;
typedef short bf16x8 __attribute__((ext_vector_type(8)));
typedef short s16x4 __attribute__((ext_vector_type(4)));
typedef float f32x4 __attribute__((ext_vector_type(4)));
typedef float f32x16 __attribute__((ext_vector_type(16)));
typedef unsigned u32x4 __attribute__((ext_vector_type(4)));
typedef unsigned u32x2 __attribute__((ext_vector_type(2)));

constexpr int M_ = 32768, D_ = 2048, S_ = 16384, NMIX = 8192, FH = 5632;
constexpr float ALPHA = 1.41421356237f;

constexpr size_t OFF_XB = 0;
constexpr size_t OFF_WIN = 134217728;
constexpr size_t OFF_WBR = OFF_WIN + 50331648;
constexpr size_t OFF_WOUT = OFF_WBR + 8388608;
constexpr size_t OFF_MIX = 201326592;
constexpr size_t OFF_VT = 738197504;
constexpr size_t OFF_OFW = 805306368;
constexpr size_t OFF_OBW = 872415232;
constexpr size_t OFF_OB = 939524096;
constexpr size_t OFF_SGRP = 1006632960;
constexpr size_t OFF_SINT = OFF_SGRP + 16777216;
constexpr size_t OFF_GPRE = OFF_SINT + 8388608;
constexpr size_t OFF_GTOT = OFF_GPRE + 4194304;
constexpr size_t OFF_BAR = OFF_GTOT + 131072;
constexpr size_t OFF_STATS = OFF_BAR + 16384;
constexpr size_t WS_END = OFF_STATS + 262144;
constexpr size_t OFF_GATES = OFF_MIX;
constexpr size_t OFF_MERGED = OFF_MIX + 268435456;
constexpr size_t OFF_H = OFF_MIX;
constexpr size_t OFF_SG = OFF_MIX + 369098752;
constexpr size_t OFF_WUPG = OFF_OFW;
constexpr size_t OFF_WDOWN = OFF_WUPG + 54525952;
constexpr size_t OFF_WPE = OFF_WDOWN + 23068672;
constexpr size_t OFF_PB = OFF_WPE + 1048576;

struct P {
    const float *x, *p, *w_in, *b_in, *lbl, *ang, *rpb, *w_branch, *w_out, *ln1g, *ln1b, *w_up, *w_down, *w_pe, *w_pg, *ln2g, *ln2b;
    float* out; unsigned char* ws; int ph_lo, ph_hi, coop, pad;
};

typedef __bf16 bf16v2 __attribute__((ext_vector_type(2)));
typedef float f32x2 __attribute__((ext_vector_type(2)));
__device__ __forceinline__ unsigned cvt_pk_bf16(float lo, float hi) { f32x2 f = {lo, hi}; bf16v2 b = __builtin_convertvector(f, bf16v2); return __builtin_bit_cast(unsigned, b); }
__device__ __forceinline__ float shx(float v, int o, int lane) { return __int_as_float(__builtin_amdgcn_ds_bpermute((lane ^ o) << 2, __float_as_int(v))); }
__device__ __forceinline__ float bf_lo(unsigned w) { return __uint_as_float(w << 16); }
__device__ __forceinline__ float bf_hi(unsigned w) { return __uint_as_float(w & 0xffff0000u); }
__device__ __forceinline__ float bf2f(u16 b) { return __uint_as_float(((unsigned)b) << 16); }
__device__ __forceinline__ u16 f2bf(float f) { return (u16)(cvt_pk_bf16(f, 0.f) & 0xffffu); }
__device__ __forceinline__ float fexp(float v) { return __builtin_amdgcn_exp2f(v * 1.44269504089f); }
__device__ __forceinline__ float sigm(float v) { return __builtin_amdgcn_rcpf(1.0f + fexp(-v)); }
__device__ __forceinline__ float silu(float v) { return v * sigm(v); }
__device__ __forceinline__ u16 f2h(float f) { _Float16 h = (_Float16)f; return __builtin_bit_cast(u16, h); }
__device__ __forceinline__ float h2f(u16 b) { return (float)__builtin_bit_cast(_Float16, b); }

constexpr int BM = 256, BK = 64, HALF = 128, HTB = HALF * BK * 2, NXCD = 8, WGM = 8;
__device__ __forceinline__ int lds_byte(int r, int c) { const int st = (r >> 4) * 2 + (c >> 5), rr = r & 15, cc = c & 31, ob = rr * 64 + cc * 2; return st * 1024 + (ob ^ (((ob >> 9) & 1) << 5)); }
__device__ __forceinline__ void stage_rc(int b, int& R, int& C) { const int st = b / 1024, sb = b % 1024, swz = sb ^ (((sb >> 9) & 1) << 5); R = (st >> 1) * 16 + swz / 64; C = (st & 1) * 32 + (swz % 64) / 2; }

struct Unit { const char* A; const char* B; int K; int pm, pn, seg, fin; };

__device__ __forceinline__ void tile_of(int L, int nM, int nN, int& pm, int& pn) {
    const int nwg = nM * nN; int wgid = L;
    { const int q = nwg / NXCD, r = nwg % NXCD, xcd = wgid % NXCD, off = wgid / NXCD; wgid = (xcd < r ? xcd * (q + 1) : r * (q + 1) + (xcd - r) * q) + off; }
    const int nig = WGM * nN, gid = wgid / nig, fm = gid * WGM, gsz = (nM - fm) < WGM ? (nM - fm) : WGM;
    pm = fm + ((wgid % nig) % gsz); pn = (wgid % nig) / gsz;
}
struct Sched1 {
    const char* A; const char* B; int K, nM, nN, pn0, bid;
    __device__ __forceinline__ bool next(int i, Unit& u) const {
        const int L = i * (int)gridDim.x + bid; if (L >= nM * nN) return false;
        tile_of(L, nM, nN, u.pm, u.pn);
        u.A = A + (size_t)u.pm * 256 * K * 2; u.B = B + (size_t)(u.pn + pn0) * 256 * K * 2; u.K = K; u.seg = 0; u.fin = 1; return true;
    }
};
struct Sched2 {
    const char *A0, *B0, *A1, *B1; int K0, K1, nM, nN, bid;
    __device__ __forceinline__ bool next(int i, Unit& u) const {
        const int L = (i >> 1) * (int)gridDim.x + bid; if (L >= nM * nN) return false;
        tile_of(L, nM, nN, u.pm, u.pn); const int sg = i & 1; const int K = sg ? K1 : K0;
        u.A = (sg ? A1 : A0) + (size_t)u.pm * 256 * K * 2; u.B = (sg ? B1 : B0) + (size_t)u.pn * 256 * K * 2; u.K = K; u.seg = sg; u.fin = sg; return true;
    }
};

template <class Sched, class Epi>
__device__ __forceinline__ void gemm_phase(LAS unsigned char* lds, const Sched& S, const Epi& E, const int tid) {
    const int wid = __builtin_amdgcn_readfirstlane(tid >> 6), lane = tid & 63, wr = wid >> 2, wc = wid & 3, fr = lane & 15, fq = lane >> 4;
    int RR0, C20;
    { int R, C; stage_rc(tid * 16, R, C); RR0 = R; C20 = C * 2; }
    const size_t kstep = (size_t)(BK * 2);
    const unsigned ldsw = (unsigned)wid * 1024u;
    const int aoff = lds_byte(wr * 64 + fr, fq * 8), boff = lds_byte(wc * 32 + fr, fq * 8);
#define G_SA(b, h) (((b) * 2 + (h)) * HTB)
#define G_SB(b, h) ((4 + (b) * 2 + (h)) * HTB)
#define G_STAGE(bufoff, gbase, ld2) do { _Pragma("unroll") for (int _i = 0; _i < 2; ++_i) \
        __builtin_amdgcn_global_load_lds((const unsigned*)((const char*)(gbase) + (unsigned)((RR0 + 64 * _i) * (ld2) + C20)), (LAS unsigned*)(lds + (bufoff) + ldsw + _i * 8192), 16, 0, 0); } while (0)
#define G_LDA(dst, b, h) do { _Pragma("unroll") for (int m = 0; m < 4; ++m) _Pragma("unroll") for (int k = 0; k < 2; ++k) dst[m][k] = *(const LAS bf16x8*)(lds + G_SA(b, h) + aoff + m * 2048 + k * 1024); } while (0)
#define G_LDB(dst, b, h) do { _Pragma("unroll") for (int n = 0; n < 2; ++n) _Pragma("unroll") for (int k = 0; k < 2; ++k) dst[n][k] = *(const LAS bf16x8*)(lds + G_SB(b, h) + boff + n * 2048 + k * 1024); } while (0)
#define G_MMA(ai, bj, At, Bt) do { __builtin_amdgcn_s_setprio(1); _Pragma("unroll") for (int m = 0; m < 4; ++m) _Pragma("unroll") for (int n = 0; n < 2; ++n) _Pragma("unroll") for (int k = 0; k < 2; ++k) \
        acc[ai][bj][m][n] = __builtin_amdgcn_mfma_f32_16x16x32_bf16(Bt[n][k], At[m][k], acc[ai][bj][m][n], 0, 0, 0); __builtin_amdgcn_s_setprio(0); } while (0)
#define G_WAIT_V(n) asm volatile("s_waitcnt vmcnt(" #n ")" ::: "memory")
#define G_WAIT_L(n) asm volatile("s_waitcnt lgkmcnt(" #n ")" ::: "memory")
#define G_BAR __builtin_amdgcn_s_barrier()
#define G_SCHED __builtin_amdgcn_sched_barrier(0)
    Unit cur, nxt; int ui = 0;
    if (!S.next(0, cur)) return;
    f32x4 acc[2][2][4][2];
#pragma unroll
    for (int a = 0; a < 2; ++a)
#pragma unroll
        for (int b = 0; b < 2; ++b)
#pragma unroll
            for (int m = 0; m < 4; ++m)
#pragma unroll
                for (int n = 0; n < 2; ++n) acc[a][b][m][n] = (f32x4){0.f, 0.f, 0.f, 0.f};
    bf16x8 At[4][2], B0[2][2], B1[2][2];
    const char* cA = cur.A; const char* cB = cur.B;
    {
        const int ld2 = cur.K * 2; const size_t hstep = (size_t)HALF * ld2;
        G_STAGE(G_SB(0, 0), cB, ld2); G_STAGE(G_SA(0, 0), cA, ld2); G_STAGE(G_SB(0, 1), cB + hstep, ld2); G_STAGE(G_SA(0, 1), cA + hstep, ld2);
        if (wr == 1) G_BAR;
        G_WAIT_V(4); G_BAR;
        G_STAGE(G_SB(1, 0), cB + kstep, ld2); G_STAGE(G_SA(1, 0), cA + kstep, ld2); G_STAGE(G_SB(1, 1), cB + hstep + kstep, ld2);
        G_WAIT_V(6); G_BAR;
    }
    for (;;) {
        const bool has_next = S.next(ui + 1, nxt);
        const char* nA = has_next ? nxt.A : cA; const char* nB = has_next ? nxt.B : cB;
        const int ld2c = cur.K * 2, ld2n = has_next ? nxt.K * 2 : ld2c;
        const size_t hstepc = (size_t)HALF * ld2c;
        const int nt = cur.K / BK;
        for (int t = 0; t < nt; t += 2) {
            const bool last = (t == nt - 2);
            const char* a1 = cA + (size_t)(t + 1) * kstep;
            const char* a2 = last ? nA : cA + (size_t)(t + 2) * kstep; const char* b2 = last ? nB : cB + (size_t)(t + 2) * kstep;
            const int ld2x = last ? ld2n : ld2c; const size_t hstepx = (size_t)HALF * ld2x;
            const char* a3 = a2 + kstep; const char* b3 = b2 + kstep;
            G_LDB(B0, 0, 0); G_SCHED; G_LDA(At, 0, 0); G_STAGE(G_SA(1, 1), a1 + hstepc, ld2c);
            G_WAIT_L(8); G_BAR; G_WAIT_L(0); G_MMA(0, 0, At, B0); G_BAR; G_SCHED;
            G_LDB(B1, 0, 1); G_STAGE(G_SB(0, 0), b2, ld2x);
            G_BAR; G_WAIT_L(0); G_MMA(0, 1, At, B1); G_BAR;
            G_LDA(At, 0, 1); G_STAGE(G_SA(0, 0), a2, ld2x);
            G_BAR; G_WAIT_L(0); G_MMA(1, 0, At, B0); G_BAR; G_SCHED;
            G_STAGE(G_SB(0, 1), b2 + hstepx, ld2x);
            G_WAIT_V(6); G_BAR; G_MMA(1, 1, At, B1); G_BAR;
            G_LDB(B0, 1, 0); G_SCHED; G_LDA(At, 1, 0); G_STAGE(G_SA(0, 1), a2 + hstepx, ld2x);
            G_WAIT_L(8); G_BAR; G_WAIT_L(0); G_MMA(0, 0, At, B0); G_BAR; G_SCHED;
            G_LDB(B1, 1, 1); G_STAGE(G_SB(1, 0), b3, ld2x);
            G_BAR; G_WAIT_L(0); G_MMA(0, 1, At, B1); G_BAR;
            G_LDA(At, 1, 1); G_STAGE(G_SA(1, 0), a3, ld2x);
            G_BAR; G_WAIT_L(0); G_MMA(1, 0, At, B0); G_BAR; G_SCHED;
            G_STAGE(G_SB(1, 1), b3 + hstepx, ld2x);
            G_WAIT_V(6); G_BAR; G_MMA(1, 1, At, B1); G_BAR;
        }
        E(acc, cur, wr, wc, fr, fq);
        if (!has_next) break;
        if (cur.fin) {
#pragma unroll
            for (int a = 0; a < 2; ++a)
#pragma unroll
                for (int b = 0; b < 2; ++b)
#pragma unroll
                    for (int m = 0; m < 4; ++m)
#pragma unroll
                        for (int n = 0; n < 2; ++n) acc[a][b][m][n] = (f32x4){0.f, 0.f, 0.f, 0.f};
        }
        cur = nxt; cA = nA; cB = nB; ++ui;
    }
    G_WAIT_V(0);
    if (wr == 0) G_BAR;
    G_BAR;
#undef G_SA
#undef G_SB
#undef G_STAGE
#undef G_LDA
#undef G_LDB
#undef G_MMA
}

#define EPI_LOOP_BN _Pragma("unroll") for (int bj = 0; bj < 2; ++bj) _Pragma("unroll") for (int n = 0; n < 2; ++n)
#define EPI_LOOP_AM _Pragma("unroll") for (int ai = 0; ai < 2; ++ai) _Pragma("unroll") for (int m = 0; m < 4; ++m)

__device__ __forceinline__ u32x4 pack8(const f32x4 a, const f32x4 b) { u32x4 w; w.x = cvt_pk_bf16(a[0], a[1]); w.y = cvt_pk_bf16(a[2], a[3]); w.z = cvt_pk_bf16(b[0], b[1]); w.w = cvt_pk_bf16(b[2], b[3]); return w; }
#define EPI_LOOP_B _Pragma("unroll") for (int bj = 0; bj < 2; ++bj)
#define EPI_LOOP_N _Pragma("unroll") for (int n = 0; n < 2; ++n)

struct EpiG1a {
    u16* mix; u16* vT; const float* bias; const float* lbl; int layer;
    __device__ __forceinline__ void operator()(f32x4 (&acc)[2][2][4][2], const Unit& u, int wr, int wc, int fr, int fq) const {
        const int type = u.pn >> 2;
        const int row0 = u.pm * 256 + wr * 64 + fr, colb = u.pn * 256 + wc * 32 + 8 * fq;
        f32x4 bvh[2][2], lbh[2][2];
        EPI_LOOP_B { EPI_LOOP_N { bvh[bj][n] = *(const f32x4*)(bias + colb + bj * 128 + 4 * n); lbh[bj][n] = (f32x4){0.f, 0.f, 0.f, 0.f}; } }
        if ((type == 3 || type == 4) && layer == 1) {
            const int dir = type - 3;
            EPI_LOOP_B { EPI_LOOP_N {
                const int cc = colb + bj * 128 - 3072 - dir * 1024 + 4 * n;
                const f32x4 l0 = *(const f32x4*)(lbl + dir * 1024 + cc), l1 = *(const f32x4*)(lbl + (2 + dir) * 1024 + cc);
#pragma unroll
                for (int e = 0; e < 4; ++e) lbh[bj][n][e] = sigm(l1[e] - l0[e]);
            } }
        }
        EPI_LOOP_B {
            const int c8 = colb + bj * 128;
            f32x4 bv[2], lb[2];
            EPI_LOOP_N { bv[n] = bvh[bj][n]; lb[n] = lbh[bj][n]; }
            EPI_LOOP_AM {
                const int r = row0 + ai * 128 + m * 16;
                f32x4 v[2];
                EPI_LOOP_N v[n] = acc[ai][bj][m][n] + bv[n];
                if (type == 7) {
                    const int b = r >> 14, s = r & 16383, hd = c8 - 7168;
                    EPI_LOOP_N {
#pragma unroll
                        for (int e = 0; e < 4; ++e) vT[((size_t)(b * 1024 + hd + 4 * n + e)) * 16384 + s] = f2bf(v[n][e]);
                    }
                } else {
                    u32x4 w;
                    if (type == 3 || type == 4) {
                        unsigned hw[2][2];
                        EPI_LOOP_N {
                            float o[4];
#pragma unroll
                            for (int e = 0; e < 4; ++e) { float f = lb[n][e] + (1.0f - lb[n][e]) * sigm(v[n][e]); f = fminf(fmaxf(f, 1e-6f), 1.0f); o[e] = __builtin_amdgcn_logf(f) * 0.69314718056f; }
                            hw[n][0] = (unsigned)f2h(o[0]) | ((unsigned)f2h(o[1]) << 16); hw[n][1] = (unsigned)f2h(o[2]) | ((unsigned)f2h(o[3]) << 16);
                        }
                        w.x = hw[0][0]; w.y = hw[0][1]; w.z = hw[1][0]; w.w = hw[1][1];
                    } else {
                        if (type == 0 || type == 2) {
                            EPI_LOOP_N {
#pragma unroll
                                for (int e = 0; e < 4; ++e) v[n][e] = silu(v[n][e]);
                            }
                        } else if (type == 5) { v[0] = v[0] * 0.08838834764831845f; v[1] = v[1] * 0.08838834764831845f; }
                        w = pack8(v[0], v[1]);
                    }
                    *(u32x4*)(mix + (size_t)r * NMIX + c8) = w;
                }
            }
        }
    }
};
struct EpiG1b {
    u16* gates; const float* bias;
    __device__ __forceinline__ void operator()(f32x4 (&acc)[2][2][4][2], const Unit& u, int wr, int wc, int fr, int fq) const {
        const int row0 = u.pm * 256 + wr * 64 + fr, colb = u.pn * 256 + wc * 32 + 8 * fq;
        f32x4 bvh[2][2];
        EPI_LOOP_B { EPI_LOOP_N bvh[bj][n] = *(const f32x4*)(bias + 8192 + colb + bj * 128 + 4 * n); }
        EPI_LOOP_B {
            const int c8 = colb + bj * 128;
            const f32x4 bv0 = bvh[bj][0], bv1 = bvh[bj][1];
            EPI_LOOP_AM {
                const int r = row0 + ai * 128 + m * 16;
                f32x4 v0 = acc[ai][bj][m][0] + bv0, v1 = acc[ai][bj][m][1] + bv1;
#pragma unroll
                for (int e = 0; e < 4; ++e) { v0[e] = sigm(v0[e]); v1[e] = sigm(v1[e]); }
                *(u32x4*)(gates + (size_t)r * 4096 + c8) = pack8(v0, v1);
            }
        }
    }
};
struct EpiG3 {
    const u16* gates; u16* merged;
    __device__ __forceinline__ void operator()(f32x4 (&acc)[2][2][4][2], const Unit& u, int wr, int wc, int fr, int fq) const {
        const int row0 = u.pm * 256 + wr * 64 + fr, colb = u.pn * 256 + wc * 32 + 8 * fq;
        EPI_LOOP_B {
            const int c8 = colb + bj * 128;
#pragma unroll
            for (int ai = 0; ai < 2; ++ai) {
                u32x4 gbw[4], gaw[4];
#pragma unroll
                for (int m = 0; m < 4; ++m) { const int r = row0 + ai * 128 + m * 16; gbw[m] = *(const u32x4*)(gates + (size_t)r * 4096 + 2048 + c8); }
                if (u.seg == 0) {
#pragma unroll
                    for (int m = 0; m < 4; ++m) { const int r = row0 + ai * 128 + m * 16; gaw[m] = *(const u32x4*)(gates + (size_t)r * 4096 + c8); }
#pragma unroll
                    for (int m = 0; m < 4; ++m) {
                        EPI_LOOP_N {
                            f32x4 v = acc[ai][bj][m][n];
                            v[0] *= bf_lo(gaw[m][2 * n]) * __builtin_amdgcn_rcpf(bf_lo(gbw[m][2 * n])); v[1] *= bf_hi(gaw[m][2 * n]) * __builtin_amdgcn_rcpf(bf_hi(gbw[m][2 * n]));
                            v[2] *= bf_lo(gaw[m][2 * n + 1]) * __builtin_amdgcn_rcpf(bf_lo(gbw[m][2 * n + 1])); v[3] *= bf_hi(gaw[m][2 * n + 1]) * __builtin_amdgcn_rcpf(bf_hi(gbw[m][2 * n + 1]));
                            acc[ai][bj][m][n] = v;
                        }
                    }
                } else {
#pragma unroll
                    for (int m = 0; m < 4; ++m) {
                        const int r = row0 + ai * 128 + m * 16;
                        f32x4 v[2];
                        EPI_LOOP_N { v[n] = acc[ai][bj][m][n]; v[n][0] *= bf_lo(gbw[m][2 * n]); v[n][1] *= bf_hi(gbw[m][2 * n]); v[n][2] *= bf_lo(gbw[m][2 * n + 1]); v[n][3] *= bf_hi(gbw[m][2 * n + 1]); }
                        *(u32x4*)(merged + (size_t)r * 2048 + c8) = pack8(v[0], v[1]);
                    }
                }
            }
        }
    }
};
template <int LN> struct EpiG4 {
    const float* xres; float* y; const float* stats; const float* g; const float* b;
    __device__ __forceinline__ void operator()(f32x4 (&acc)[2][2][4][2], const Unit& u, int wr, int wc, int fr, int fq) const {
        const int row0 = u.pm * 256 + wr * 64 + fr, colb = u.pn * 256 + wc * 32 + 8 * fq;
        f32x4 xr[2][4], gv[2], bv[2]; f32x2 st[2][4];
#define G4_LOAD(k) do { const int ai_ = (k) >> 2, c_ = colb + (((k) >> 1) & 1) * 128 + 4 * ((k) & 1); \
            if (LN) { gv[(k) & 1] = *(const f32x4*)(g + c_); bv[(k) & 1] = *(const f32x4*)(b + c_); } \
            _Pragma("unroll") for (int m = 0; m < 4; ++m) { const int r_ = row0 + ai_ * 128 + m * 16; xr[(k) & 1][m] = *(const f32x4*)(xres + (size_t)r_ * 2048 + c_); \
                if (LN) st[(k) & 1][m] = *(const f32x2*)(stats + 2 * r_); } } while (0)
        G4_LOAD(0);
#pragma unroll
        for (int k = 0; k < 8; ++k) {
            if (k < 7) G4_LOAD(k + 1);
            const int ai = k >> 2, bj = (k >> 1) & 1, n = k & 1, c = colb + bj * 128 + 4 * n;
#pragma unroll
            for (int m = 0; m < 4; ++m) {
                f32x4 x = xr[k & 1][m];
                if (LN) x = (x - st[k & 1][m][0]) * st[k & 1][m][1] * gv[k & 1] + bv[k & 1];
                *(f32x4*)(y + (size_t)(row0 + ai * 128 + m * 16) * 2048 + c) = x * ALPHA + acc[ai][bj][m][n];
            }
        }
#undef G4_LOAD
    }
};
struct EpiG6 {
    u16* h; u16* sg;
    __device__ __forceinline__ void operator()(f32x4 (&acc)[2][2][4][2], const Unit& u, int wr, int wc, int fr, int fq) const {
        const int row0 = u.pm * 256 + wr * 64 + fr;
        if (u.pn < 44) {
            const int hc = u.pn * 128 + wc * 32 + 8 * fq;
            EPI_LOOP_AM {
                const int r = row0 + ai * 128 + m * 16;
                f32x4 o0, o1;
#pragma unroll
                for (int e = 0; e < 4; ++e) { o0[e] = silu(acc[ai][0][m][0][e]) * acc[ai][0][m][1][e]; o1[e] = silu(acc[ai][1][m][0][e]) * acc[ai][1][m][1][e]; }
                *(u32x4*)(h + (size_t)r * FH + hc) = pack8(o0, o1);
            }
        } else {
            const int colb = (u.pn - 44) * 256 + wc * 32 + 8 * fq;
            EPI_LOOP_B {
                const int c8 = colb + bj * 128;
                EPI_LOOP_AM {
                    const int r = row0 + ai * 128 + m * 16;
                    f32x4 v0 = acc[ai][bj][m][0], v1 = acc[ai][bj][m][1];
#pragma unroll
                    for (int e = 0; e < 4; ++e) { v0[e] = sigm(v0[e]); v1[e] = sigm(v1[e]); }
                    *(u32x4*)(sg + (size_t)r * 2048 + c8) = pack8(v0, v1);
                }
            }
        }
    }
};
struct EpiG7 {
    const u16* sg; float* y; const float* stats; const float* g; const float* b;
    __device__ __forceinline__ void operator()(f32x4 (&acc)[2][2][4][2], const Unit& u, int wr, int wc, int fr, int fq) const {
        const int row0 = u.pm * 256 + wr * 64 + fr, colb = u.pn * 256 + wc * 32 + 8 * fq;
        if (u.seg == 0) {
            EPI_LOOP_B {
                const int c8 = colb + bj * 128;
                u32x4 sv[2][4];
                EPI_LOOP_AM { const int r = row0 + ai * 128 + m * 16; sv[ai][m] = *(const u32x4*)(sg + (size_t)r * 2048 + c8); }
                EPI_LOOP_AM {
                    EPI_LOOP_N {
                        f32x4 v = acc[ai][bj][m][n];
                        v[0] *= bf_lo(sv[ai][m][2 * n]); v[1] *= bf_hi(sv[ai][m][2 * n]); v[2] *= bf_lo(sv[ai][m][2 * n + 1]); v[3] *= bf_hi(sv[ai][m][2 * n + 1]);
                        acc[ai][bj][m][n] = v;
                    }
                }
            }
        } else {
#pragma unroll
            for (int ai = 0; ai < 2; ++ai) {
                f32x2 st[4];
#pragma unroll
                for (int m = 0; m < 4; ++m) st[m] = *(const f32x2*)(stats + 2 * (row0 + ai * 128 + m * 16));
                EPI_LOOP_BN {
                    const int c = colb + bj * 128 + 4 * n;
                    const f32x4 gv = *(const f32x4*)(g + c), bv = *(const f32x4*)(b + c);
                    f32x4 xr[4];
#pragma unroll
                    for (int m = 0; m < 4; ++m) xr[m] = *(const f32x4*)(y + (size_t)(row0 + ai * 128 + m * 16) * 2048 + c);
#pragma unroll
                    for (int m = 0; m < 4; ++m) {
                        const f32x4 x1 = (xr[m] - st[m][0]) * st[m][1] * gv + bv;
                        *(f32x4*)(y + (size_t)(row0 + ai * 128 + m * 16) * 2048 + c) = x1 * ALPHA + acc[ai][bj][m][n];
                    }
                }
            }
        }
    }
};

template <int PERM>
__device__ __forceinline__ void convT(const float* src, int ldsrc, int K, int N, u16* dst, LAS float* tl, const int tid, const int bid) {
    const int nkt = K >> 6, nnt = N >> 7;
    for (int T = bid; T < nkt * nnt; T += gridDim.x) {
        const int kt = T % nkt, ntile = T / nkt; const int k0 = kt << 6, n0 = ntile << 7;
        const int nn = tid & 127; const int rho = n0 + nn;
        int sc;
        if (PERM) { const int R = rho & 255; const int j = (rho >> 8) * 128 + 32 * ((R >> 5) & 3) + 8 * ((R >> 2) & 3) + 4 * (R >> 7) + (R & 3); sc = ((R >> 4) & 1) ? FH + j : j; }
        else { const int q = rho & 31; sc = (rho & ~31) + 8 * ((q & 15) >> 2) + 4 * (q >> 4) + (q & 3); }
        float ld[16];
#pragma unroll
        for (int i = 0; i < 16; ++i) ld[i] = src[(size_t)(k0 + (tid >> 7) + 4 * i) * ldsrc + sc];
#pragma unroll
        for (int i = 0; i < 16; ++i) tl[((tid >> 7) + 4 * i) * 129 + nn] = ld[i];
        __syncthreads();
        const int n2 = tid >> 2, k16 = (tid & 3) << 4;
        float v[16];
#pragma unroll
        for (int j = 0; j < 16; ++j) v[j] = tl[(k16 + j) * 129 + n2];
        u32x4 w0, w1;
#pragma unroll
        for (int j = 0; j < 4; ++j) { w0[j] = cvt_pk_bf16(v[2 * j], v[2 * j + 1]); w1[j] = cvt_pk_bf16(v[8 + 2 * j], v[9 + 2 * j]); }
        u16* dp = dst + (size_t)(n0 + n2) * K + k0 + k16;
        *(u32x4*)dp = w0; *(u32x4*)(dp + 8) = w1;
        __syncthreads();
    }
}
__device__ __forceinline__ void cvt_flat(const float* src, u16* dst, size_t n4, const int tid, const int bid) {
    const size_t stride = (size_t)gridDim.x * 512;
    size_t i = (size_t)bid * 512 + tid;
    for (; i + 3 * stride < n4; i += 4 * stride) {
        f32x4 v[4];
#pragma unroll
        for (int j = 0; j < 4; ++j) v[j] = *(const f32x4*)(src + (i + j * stride) * 4);
#pragma unroll
        for (int j = 0; j < 4; ++j) { u32x2 w; w.x = cvt_pk_bf16(v[j][0], v[j][1]); w.y = cvt_pk_bf16(v[j][2], v[j][3]); *(u32x2*)(dst + (i + j * stride) * 4) = w; }
    }
    for (; i < n4; i += stride) {
        const f32x4 v = *(const f32x4*)(src + i * 4);
        u32x2 w; w.x = cvt_pk_bf16(v[0], v[1]); w.y = cvt_pk_bf16(v[2], v[3]);
        *(u32x2*)(dst + i * 4) = w;
    }
}
__device__ __forceinline__ void conv_A(const P& p, unsigned char* ws, int l, LAS unsigned char* lds, const int tid, const int bid) {
    LAS float* tl = (LAS float*)lds;
    convT<0>(p.w_in + (size_t)l * 2048 * 12288, 12288, 2048, 12288, (u16*)(ws + OFF_WIN), tl, tid, bid);
    convT<0>(p.w_branch + (size_t)(l * 2 + 0) * 1024 * 2048, 2048, 1024, 2048, (u16*)(ws + OFF_WBR), tl, tid, bid);
    convT<0>(p.w_branch + (size_t)(l * 2 + 1) * 1024 * 2048, 2048, 1024, 2048, (u16*)(ws + OFF_WBR) + 2048 * 1024, tl, tid, bid);
    convT<0>(p.w_out + (size_t)l * 2048 * 2048, 2048, 2048, 2048, (u16*)(ws + OFF_WOUT), tl, tid, bid);
}
__device__ __forceinline__ void conv_B(const P& p, unsigned char* ws, int l, LAS unsigned char* lds, const int tid, const int bid) {
    LAS float* tl = (LAS float*)lds;
    convT<1>(p.w_up + (size_t)l * 2048 * 11264, 11264, 2048, 11264, (u16*)(ws + OFF_WUPG), tl, tid, bid);
    convT<0>(p.w_pg + (size_t)l * 2048 * 2048, 2048, 2048, 2048, (u16*)(ws + OFF_WUPG) + (size_t)11264 * 2048, tl, tid, bid);
    convT<0>(p.w_down + (size_t)l * FH * 2048, 2048, FH, 2048, (u16*)(ws + OFF_WDOWN), tl, tid, bid);
    convT<0>(p.w_pe + (size_t)l * 256 * 2048, 2048, 256, 2048, (u16*)(ws + OFF_WPE), tl, tid, bid);
    cvt_flat(p.p + (size_t)l * M_ * 256, (u16*)(ws + OFF_PB), (size_t)M_ * 256 / 4, tid, bid);
}

template <int FULL>
__device__ __forceinline__ void ln_phase(float* y, const float* g, const float* b, u16* xb, float* stats, const int tid, const int bid) {
    constexpr int NR = 4;
    const int lane = tid & 63, wid = tid >> 6;
    const int nw = (int)gridDim.x * 8;
    for (int row0 = bid * 8 + wid; row0 < M_; row0 += NR * nw) {
        f32x4 v[NR][8]; float s[NR], q[NR];
#pragma unroll
        for (int k = 0; k < NR; ++k) { const int row = min(row0 + k * nw, M_ - 1); const float* yp = y + (size_t)row * 2048 + lane * 4;
#pragma unroll
            for (int i = 0; i < 8; ++i) v[k][i] = *(const f32x4*)(yp + i * 256); }
#pragma unroll
        for (int k = 0; k < NR; ++k) { s[k] = 0.f;
#pragma unroll
            for (int i = 0; i < 8; ++i) s[k] += (v[k][i][0] + v[k][i][1]) + (v[k][i][2] + v[k][i][3]); }
#pragma unroll
        for (int o = 32; o >= 1; o >>= 1)
#pragma unroll
            for (int k = 0; k < NR; ++k) s[k] += shx(s[k], o, lane);
#pragma unroll
        for (int k = 0; k < NR; ++k) { s[k] *= (1.0f / 2048.0f); q[k] = 0.f;
#pragma unroll
            for (int i = 0; i < 8; ++i) { const f32x4 d = v[k][i] - s[k]; q[k] += (d[0] * d[0] + d[1] * d[1]) + (d[2] * d[2] + d[3] * d[3]); } }
#pragma unroll
        for (int o = 32; o >= 1; o >>= 1)
#pragma unroll
            for (int k = 0; k < NR; ++k) q[k] += shx(q[k], o, lane);
#pragma unroll
        for (int k = 0; k < NR; ++k) q[k] = rsqrtf(q[k] * (1.0f / 2048.0f) + 1e-5f);
#pragma unroll
        for (int i = 0; i < 8; ++i) {
            const f32x4 gv = *(const f32x4*)(g + i * 256 + lane * 4), bv = *(const f32x4*)(b + i * 256 + lane * 4);
#pragma unroll
            for (int k = 0; k < NR; ++k) {
                const int row = row0 + k * nw;
                if (row < M_) {
                    const f32x4 o = (v[k][i] - s[k]) * q[k] * gv + bv;
                    if (FULL) *(f32x4*)(y + (size_t)row * 2048 + lane * 4 + i * 256) = o;
                    else if (i == 0 && lane == 0) *(f32x2*)(stats + 2 * row) = (f32x2){s[k], q[k]};
                    u32x2 w; w.x = cvt_pk_bf16(o[0], o[1]); w.y = cvt_pk_bf16(o[2], o[3]);
                    *(u32x2*)(xb + (size_t)row * 2048 + i * 256 + lane * 4) = w;
                }
            }
        }
    }
}

__device__ __forceinline__ void post_phase(const P& p, unsigned char* ws, int l, const int tid, const int bid) {
    u16* ofw = (u16*)(ws + OFF_OFW); const u16* obw = (const u16*)(ws + OFF_OBW); const u16* mix = (const u16*)(ws + OFF_MIX);
    const float* ng = p.ang + l * 1024;
    const int lane = tid & 63, wid = tid >> 6;
    const int nw = (int)gridDim.x * 8, NWI = M_ * 8 / 4;
    for (int wi0 = bid * 8 + wid; wi0 < NWI; wi0 += 4 * nw) {
        u32x4 a[4], bq[4], gt[4];
#pragma unroll
        for (int k = 0; k < 4; ++k) {
            const int wi = min(wi0 + k * nw, NWI - 1);
            const int idx = wi * 4 + (lane >> 4); const int tok = idx >> 3, hh = idx & 7, e0 = (lane & 15) * 8;
            a[k] = *(const u32x4*)(ofw + (size_t)tok * 1024 + hh * 128 + e0); bq[k] = *(const u32x4*)(obw + (size_t)tok * 1024 + hh * 128 + e0);
            gt[k] = *(const u32x4*)(mix + (size_t)tok * NMIX + 2048 + hh * 128 + e0);
        }
#pragma unroll
        for (int k = 0; k < 4; ++k) {
            const int wi = wi0 + k * nw;
            const int idx = wi * 4 + (lane >> 4); const int tok = idx >> 3, hh = idx & 7, e0 = (lane & 15) * 8;
            float o[8];
#pragma unroll
            for (int j = 0; j < 4; ++j) { o[2 * j] = bf_lo(a[k][j]) + bf_lo(bq[k][j]); o[2 * j + 1] = bf_hi(a[k][j]) + bf_hi(bq[k][j]); }
            float ss = 0.f;
#pragma unroll
            for (int j = 0; j < 8; ++j) ss += o[j] * o[j];
            ss += shx(ss, 1, lane); ss += shx(ss, 2, lane); ss += shx(ss, 4, lane); ss += shx(ss, 8, lane);
            const float rs = rsqrtf(ss * (1.0f / 128.0f) + 1e-6f);
            const f32x4 g0 = *(const f32x4*)(ng + hh * 128 + e0), g1 = *(const f32x4*)(ng + hh * 128 + e0 + 4);
            u32x4 w;
#pragma unroll
            for (int j = 0; j < 4; ++j) {
                const float gl = (j < 2) ? g0[2 * j] : g1[2 * j - 4], gh = (j < 2) ? g0[2 * j + 1] : g1[2 * j - 3];
                w[j] = cvt_pk_bf16(o[2 * j] * rs * gl * bf_lo(gt[k][j]), o[2 * j + 1] * rs * gh * bf_hi(gt[k][j]));
            }
            if (wi < NWI) *(u32x4*)(ofw + (size_t)tok * 1024 + hh * 128 + e0) = w;
        }
    }
}

constexpr int R_QG = 0, R_QM = 17408, R_KM = 34816, R_KDT = 52224, R_VT = 70656, R_ATT = 89088, R_DV = 98304, R_TOT = 98816;
__device__ __forceinline__ void rec1_phase(unsigned char* ws, LAS unsigned char* lds, const int tid, const int item) {
    const int wid = __builtin_amdgcn_readfirstlane(tid >> 6), lane = tid & 63;
    const int seq = item & 31, grp = item >> 5; const int dir = seq & 1, hh = (seq >> 1) & 7, b = seq >> 4;
    const u16* mix = (const u16*)(ws + OFF_MIX);
    u16* odir = (u16*)(ws + (dir ? OFF_OBW : OFF_OFW));
    const int sg = wid, c2 = 2 * lane;
    const int r = lane & 31, h = lane >> 5;
    const int kcp = (c2 & ~15) + 8 * ((c2 >> 2) & 1) + 4 * ((c2 >> 3) & 1) + (c2 & 3);
    LAS float* TOT = (LAS float*)(lds + R_TOT); LAS float* DV = (LAS float*)(lds + R_DV);
    f32x16 S[4];
#pragma unroll
    for (int kb = 0; kb < 4; ++kb)
#pragma unroll
        for (int e = 0; e < 16; ++e) S[kb][e] = 0.f;
    unsigned nlf[8], nq[8], nv[8];
    {
        const int co = dir ? 255 - grp * 32 : grp * 32; const size_t tok0 = (size_t)b * S_ + (size_t)co * 64;
#pragma unroll
        for (int i = 0; i < 8; ++i) { const int tau = 8 * sg + i, t = dir ? 63 - tau : tau; const u16* rp = mix + (tok0 + t) * NMIX + hh * 128 + c2;
            nlf[i] = *(const unsigned*)(rp + 3072 + dir * 1024); nq[i] = *(const unsigned*)(rp); nv[i] = *(const unsigned*)(rp + 1024); }
    }
    float gpre0 = 0.f, gpre1 = 0.f;
    float* GPRE = (float*)(ws + OFF_GPRE);
    for (int c = grp * 32; c < grp * 32 + 32; ++c) {
        const int co = dir ? 255 - c : c; const size_t tok0 = (size_t)b * S_ + (size_t)co * 64;
        float g0[8], g1[8]; float cs0 = 0.f, cs1 = 0.f;
#pragma unroll
        for (int i = 0; i < 8; ++i) { cs0 += h2f((u16)(nlf[i] & 0xffffu)); cs1 += h2f((u16)(nlf[i] >> 16)); g0[i] = cs0; g1[i] = cs1; }
        TOT[sg * 128 + c2] = cs0; TOT[sg * 128 + c2 + 1] = cs1;
        __syncthreads();
        float pre0 = 0.f, pre1 = 0.f, ref0 = 0.f, ref1 = 0.f, gl0 = 0.f, gl1 = 0.f;
#pragma unroll
        for (int s = 0; s < 8; ++s) {
            const float a0 = TOT[s * 128 + c2], a1 = TOT[s * 128 + c2 + 1];
            if (s < sg) { pre0 += a0; pre1 += a1; }
            if (s < 4) { ref0 += a0; ref1 += a1; }
            gl0 += a0; gl1 += a1;
        }
        float kd0[8], kd1[8];
#pragma unroll
        for (int i = 0; i < 8; ++i) {
            const float gi0 = pre0 + g0[i], gi1 = pre1 + g1[i];
            const float kk0 = 1.0f - fexp(h2f((u16)(nlf[i] & 0xffffu))), kk1 = 1.0f - fexp(h2f((u16)(nlf[i] >> 16)));
            const float q0 = bf_lo(nq[i]), q1 = bf_hi(nq[i]);
            kd0[i] = kk0 * fexp(gl0 - gi0); kd1[i] = kk1 * fexp(gl1 - gi1);
            const int tau = 8 * sg + i, t = dir ? 63 - tau : tau;
            *(LAS unsigned*)(lds + R_QG + t * 272 + kcp * 2) = cvt_pk_bf16(q0 * fexp(gi0), q1 * fexp(gi1));
            *(LAS unsigned*)(lds + R_QM + t * 272 + c2 * 2) = cvt_pk_bf16(q0 * fexp(fminf(gi0 - ref0, 80.f)), q1 * fexp(fminf(gi1 - ref1, 80.f)));
            *(LAS unsigned*)(lds + R_KM + t * 272 + c2 * 2) = cvt_pk_bf16(kk0 * fexp(fminf(ref0 - gi0, 80.f)), kk1 * fexp(fminf(ref1 - gi1, 80.f)));
        }
        {
            u32x4 w0, w1, x0, x1;
#pragma unroll
            for (int j = 0; j < 4; ++j) {
                w0[j] = dir ? cvt_pk_bf16(kd0[7 - 2 * j], kd0[6 - 2 * j]) : cvt_pk_bf16(kd0[2 * j], kd0[2 * j + 1]);
                w1[j] = dir ? cvt_pk_bf16(kd1[7 - 2 * j], kd1[6 - 2 * j]) : cvt_pk_bf16(kd1[2 * j], kd1[2 * j + 1]);
                const unsigned va = dir ? nv[7 - 2 * j] : nv[2 * j], vb = dir ? nv[6 - 2 * j] : nv[2 * j + 1];
                x0[j] = (va & 0xffffu) | (vb << 16);
                x1[j] = (va >> 16) | (vb & 0xffff0000u);
            }
            const int tb0 = dir ? 56 - 8 * sg : 8 * sg;
            *(LAS u32x4*)(lds + R_KDT + c2 * 144 + tb0 * 2) = w0; *(LAS u32x4*)(lds + R_KDT + (c2 + 1) * 144 + tb0 * 2) = w1;
            *(LAS u32x4*)(lds + R_VT + c2 * 144 + tb0 * 2) = x0; *(LAS u32x4*)(lds + R_VT + (c2 + 1) * 144 + tb0 * 2) = x1;
        }
        if (sg == 0) { DV[c2] = fexp(gl0); DV[c2 + 1] = fexp(gl1); GPRE[(size_t)(seq * 256 + c) * 128 + c2] = gpre0; GPRE[(size_t)(seq * 256 + c) * 128 + c2 + 1] = gpre1; }
        gpre0 += gl0; gpre1 += gl1;
        __syncthreads();
        if (c + 1 < grp * 32 + 32) {
            const int cn = dir ? 254 - c : c + 1; const size_t tokn = (size_t)b * S_ + (size_t)cn * 64;
#pragma unroll
            for (int i = 0; i < 8; ++i) { const int tau = 8 * sg + i, t = dir ? 63 - tau : tau; const u16* rp = mix + (tokn + t) * NMIX + hh * 128 + c2;
                nlf[i] = *(const unsigned*)(rp + 3072 + dir * 1024); nq[i] = *(const unsigned*)(rp); nv[i] = *(const unsigned*)(rp + 1024); }
        }
        if (wid < 4) {
            const int sb = wid & 1, tb = wid >> 1;
            f32x16 a;
#pragma unroll
            for (int e = 0; e < 16; ++e) a[e] = 0.f;
#pragma unroll
            for (int s8 = 0; s8 < 8; ++s8) {
                const bf16x8 A = *(const LAS bf16x8*)(lds + R_KM + (32 * sb + r) * 272 + (16 * s8 + 8 * h) * 2);
                const bf16x8 B = *(const LAS bf16x8*)(lds + R_QM + (32 * tb + r) * 272 + (16 * s8 + 8 * h) * 2);
                a = __builtin_amdgcn_mfma_f32_32x32x16_bf16(A, B, a, 0, 0, 0);
            }
            const int tau = 32 * tb + r;
#pragma unroll
            for (int gq = 0; gq < 4; ++gq) {
                const int sbase = 32 * sb + 8 * gq + 4 * h;
                float o[4];
#pragma unroll
                for (int e = 0; e < 4; ++e) { const int sig = sbase + e; const bool keep = dir ? (sig >= tau) : (sig <= tau); o[e] = keep ? a[4 * gq + e] : 0.f; }
                u32x2 w; w.x = cvt_pk_bf16(o[0], o[1]); w.y = cvt_pk_bf16(o[2], o[3]);
                *(LAS u32x2*)(lds + R_ATT + tau * 144 + sbase * 2) = w;
            }
        }
        __syncthreads();
        if (wid < 4) {
            const int vs = wid;
            bf16x8 Bv[4];
#pragma unroll
            for (int s = 0; s < 4; ++s) Bv[s] = *(const LAS bf16x8*)(lds + R_VT + (32 * vs + r) * 144 + (16 * s + 8 * h) * 2);
            bf16x8 Sb[4][2];
#pragma unroll
            for (int kb = 0; kb < 4; ++kb)
#pragma unroll
                for (int s = 0; s < 2; ++s) {
                    u32x4 w;
#pragma unroll
                    for (int j = 0; j < 4; ++j) w[j] = cvt_pk_bf16(S[kb][8 * s + 2 * j], S[kb][8 * s + 2 * j + 1]);
                    Sb[kb][s] = __builtin_bit_cast(bf16x8, w);
                }
#pragma unroll
            for (int tb = 0; tb < 2; ++tb) {
                f32x16 o;
#pragma unroll
                for (int e = 0; e < 16; ++e) o[e] = 0.f;
#pragma unroll
                for (int kb = 0; kb < 4; ++kb)
#pragma unroll
                    for (int s = 0; s < 2; ++s) {
                        const bf16x8 A = *(const LAS bf16x8*)(lds + R_QG + (32 * tb + r) * 272 + (32 * kb + 16 * s + 8 * h) * 2);
                        o = __builtin_amdgcn_mfma_f32_32x32x16_bf16(A, Sb[kb][s], o, 0, 0, 0);
                    }
#pragma unroll
                for (int s = 0; s < 4; ++s) {
                    const bf16x8 A = *(const LAS bf16x8*)(lds + R_ATT + (32 * tb + r) * 144 + (16 * s + 8 * h) * 2);
                    o = __builtin_amdgcn_mfma_f32_32x32x16_bf16(A, Bv[s], o, 0, 0, 0);
                }
#pragma unroll
                for (int e = 0; e < 16; ++e) {
                    const int t = 32 * tb + (e & 3) + 8 * (e >> 2) + 4 * h;
                    odir[(tok0 + t) * 1024 + hh * 128 + 32 * vs + r] = f2bf(o[e]);
                }
            }
#pragma unroll
            for (int kb = 0; kb < 4; ++kb) {
#pragma unroll
                for (int gq = 0; gq < 4; ++gq) {
                    const f32x4 d4 = *(const LAS f32x4*)(lds + R_DV + (32 * kb + 8 * gq + 4 * h) * 4);
#pragma unroll
                    for (int e = 0; e < 4; ++e) S[kb][4 * gq + e] *= d4[e];
                }
#pragma unroll
                for (int s = 0; s < 4; ++s) {
                    const bf16x8 A = *(const LAS bf16x8*)(lds + R_KDT + (32 * kb + r) * 144 + (16 * s + 8 * h) * 2);
                    S[kb] = __builtin_amdgcn_mfma_f32_32x32x16_bf16(A, Bv[s], S[kb], 0, 0, 0);
                }
            }
        }
        __syncthreads();
    }
    if (wid < 4) {
        float* sg_out = (float*)(ws + OFF_SGRP) + (size_t)(seq * 8 + grp) * 16384;
#pragma unroll
        for (int kb = 0; kb < 4; ++kb)
#pragma unroll
            for (int e = 0; e < 16; ++e) sg_out[(32 * kb + (e & 3) + 8 * (e >> 2) + 4 * h) * 128 + 32 * wid + r] = S[kb][e];
    }
    if (sg == 0) { float* gt = (float*)(ws + OFF_GTOT) + (size_t)(seq * 8 + grp) * 128; gt[c2] = gpre0; gt[c2 + 1] = gpre1; }
}

__device__ __forceinline__ void rec2_phase(unsigned char* ws, const int tid, const int bid) {
    const float* sgrp = (const float*)(ws + OFF_SGRP); const float* gtot = (const float*)(ws + OFF_GTOT); u16* sint = (u16*)(ws + OFF_SINT);
    for (int idx = bid * 512 + tid; idx < 32 * 16384; idx += (int)gridDim.x * 512) {
        const int seq = idx >> 14, k = (idx >> 7) & 127, v = idx & 127;
        float sgv[8], gtv[8];
#pragma unroll
        for (int g = 0; g < 8; ++g) { sgv[g] = sgrp[(size_t)(seq * 8 + g) * 16384 + k * 128 + v]; gtv[g] = gtot[(seq * 8 + g) * 128 + k]; }
        float sin = 0.f;
#pragma unroll
        for (int g = 0; g < 8; ++g) {
            sint[((size_t)(seq * 8 + g) * 128 + v) * 128 + k] = f2bf(sin);
            sin = fexp(gtv[g]) * sin + sgv[g];
        }
    }
}

constexpr int R3_QC = 0, R3_TOT = 17408;
__device__ __forceinline__ void rec3_phase(unsigned char* ws, LAS unsigned char* lds, const int tid, const int bid) {
    const int wid = __builtin_amdgcn_readfirstlane(tid >> 6), lane = tid & 63;
    const u16* mix = (const u16*)(ws + OFF_MIX);
    const float* GPRE = (const float*)(ws + OFF_GPRE);
    const int sg = wid, c2 = 2 * lane, r = lane & 31, h = lane >> 5;
    LAS float* TOT = (LAS float*)(lds + R3_TOT);
    for (int u = bid; u < 32 * 224; u += (int)gridDim.x) {
        const int seq = u & 31, c = 32 + (u >> 5), grp = c >> 5;
        const int dir = seq & 1, hh = (seq >> 1) & 7, b = seq >> 4;
        const int co = dir ? 255 - c : c; const size_t tok0 = (size_t)b * S_ + (size_t)co * 64;
        u16* odir = (u16*)(ws + (dir ? OFF_OBW : OFF_OFW));
        const float gp0 = GPRE[(size_t)(seq * 256 + c) * 128 + c2], gp1 = GPRE[(size_t)(seq * 256 + c) * 128 + c2 + 1];
        if (__all((gp0 < -87.5f) && (gp1 < -87.5f))) continue;
        unsigned nlf[8], nq[8];
#pragma unroll
        for (int i = 0; i < 8; ++i) { const int tau = 8 * sg + i, t = dir ? 63 - tau : tau; const u16* rp = mix + (tok0 + t) * NMIX + hh * 128 + c2;
            nlf[i] = *(const unsigned*)(rp + 3072 + dir * 1024); nq[i] = *(const unsigned*)(rp); }
        float g0[8], g1[8]; float cs0 = 0.f, cs1 = 0.f;
#pragma unroll
        for (int i = 0; i < 8; ++i) { cs0 += h2f((u16)(nlf[i] & 0xffffu)); cs1 += h2f((u16)(nlf[i] >> 16)); g0[i] = cs0; g1[i] = cs1; }
        TOT[sg * 128 + c2] = cs0; TOT[sg * 128 + c2 + 1] = cs1;
        __syncthreads();
        float pre0 = gp0, pre1 = gp1;
#pragma unroll
        for (int s = 0; s < 8; ++s) { if (s < sg) { pre0 += TOT[s * 128 + c2]; pre1 += TOT[s * 128 + c2 + 1]; } }
#pragma unroll
        for (int i = 0; i < 8; ++i) {
            const int tau = 8 * sg + i, t = dir ? 63 - tau : tau;
            *(LAS unsigned*)(lds + R3_QC + t * 272 + c2 * 2) = cvt_pk_bf16(bf_lo(nq[i]) * fexp(pre0 + g0[i]), bf_hi(nq[i]) * fexp(pre1 + g1[i]));
        }
        __syncthreads();
        {
            const int tb = wid & 1, vq = wid >> 1;
            const u16* sin = (const u16*)(ws + OFF_SINT) + ((size_t)(seq * 8 + grp) * 128 + 32 * vq + r) * 128 + 8 * h;
            f32x16 o;
#pragma unroll
            for (int e = 0; e < 16; ++e) o[e] = 0.f;
#pragma unroll
            for (int s = 0; s < 8; ++s) {
                const bf16x8 A = *(const LAS bf16x8*)(lds + R3_QC + (32 * tb + r) * 272 + (16 * s + 8 * h) * 2);
                const bf16x8 B = *(const bf16x8*)(sin + 16 * s);
                o = __builtin_amdgcn_mfma_f32_32x32x16_bf16(A, B, o, 0, 0, 0);
            }
            u16* op0 = odir + (tok0 + 32 * tb + 4 * h) * 1024 + hh * 128 + 32 * vq + r;
            u16 old[16];
#pragma unroll
            for (int e = 0; e < 16; ++e) old[e] = op0[((e & 3) + 8 * (e >> 2)) * 1024];
#pragma unroll
            for (int e = 0; e < 16; ++e) op0[((e & 3) + 8 * (e >> 2)) * 1024] = f2bf(bf2f(old[e]) + o[e]);
        }
        __syncthreads();
    }
}

__device__ __forceinline__ void na_phase(const P& p, unsigned char* ws, int l, LAS unsigned char* lds, int blk0, const int tid, const int bid) {
    const int wid = tid >> 6, lane = tid & 63, q15 = lane & 15, g = lane >> 4;
    LAS float* rp = (LAS float*)(lds + 256);
    {
        float tv[8];
#pragma unroll
        for (int j = 0; j < 8; ++j) { const int i = tid + j * 512; tv[j] = (i < 3720) ? p.rpb[l * 3720 + i] : 0.f; }
#pragma unroll
        for (int j = 0; j < 8; ++j) { const int i = tid + j * 512; if (i < 3720) rp[i] = tv[j]; }
    }
    __syncthreads();
    const u16* mix = (const u16*)(ws + OFF_MIX); const u16* vT = (const u16*)(ws + OFF_VT); u16* ob = (u16*)(ws + OFF_OB);
    const int nw = ((int)gridDim.x - blk0) * 8;
    const int lb = (((bid - blk0) & 7) * (((int)gridDim.x - blk0) >> 3)) + ((bid - blk0) >> 3);
    for (int item = ((((int)gridDim.x - blk0) & 7) == 0 ? lb : (bid - blk0)) * 8 + wid; item < 16384; item += nw) {
        const int j = item & 3, hh = (item >> 2) & 7, r = (item >> 5) & 255, b = item >> 13;
        const int base = b * S_;
        const int rs = min(max(r - 4, 0), 248), c0 = min(max(16 * j - 8, 0), 32);
        const int tq = base + r * 64 + 16 * j + q15;
        bf16x8 Qf[4];
#pragma unroll
        for (int ks = 0; ks < 4; ++ks) Qf[ks] = *(const bf16x8*)(mix + (size_t)tq * NMIX + 5120 + hh * 128 + 32 * ks + 8 * g);
        const u16* kbase = mix + ((size_t)(base + rs * 64 + c0 + 8 * (q15 >> 2) + (q15 & 3))) * NMIX + 6144 + hh * 128 + 8 * g;
        const u16* vbase = vT + ((size_t)((b * 8 + hh) * 128 + q15)) * 16384 + rs * 64 + c0 + 8 * g;
        bf16x8 KB[2][16];
#define NA_LOADK(bt) do { _Pragma("unroll") for (int tt = 0; tt < 4; ++tt) _Pragma("unroll") for (int ks = 0; ks < 4; ++ks) { const int t_ = 4 * (bt) + tt; \
            KB[(bt) & 1][tt * 4 + ks] = *(const bf16x8*)(kbase + (size_t)((t_ >> 1) * 64 + 4 * (t_ & 1)) * NMIX + 32 * ks); } } while (0)
#define NA_LOADV(vb) do { _Pragma("unroll") for (int dd = 0; dd < 2; ++dd) _Pragma("unroll") for (int kk = 0; kk < 8; ++kk) \
            VB[(vb) & 1][dd * 8 + kk] = *(const bf16x8*)(vbase + (size_t)(16 * (2 * (vb) + dd)) * 16384 + kk * 64); } while (0)
        f32x4 st[16];
        NA_LOADK(0); NA_LOADK(1);
        const int cq = 16 * j + q15, cs = min(max(cq - 8, 0), 48);
        const LAS float* rb0 = rp + hh * 465 + (rs - r + 7) * 31 + (c0 + 8 * g - cq + 15);
        __builtin_amdgcn_sched_barrier(0);
#pragma unroll
        for (int bt = 0; bt < 4; ++bt) {
#pragma unroll
            for (int tt = 0; tt < 4; ++tt) {
                const LAS float* rb = rb0 + ((4 * bt + tt) >> 1) * 31 + 4 * (tt & 1);
                f32x4 a = (f32x4){rb[0], rb[1], rb[2], rb[3]};
#pragma unroll
                for (int ks = 0; ks < 4; ++ks) a = __builtin_amdgcn_mfma_f32_16x16x32_bf16(KB[bt & 1][tt * 4 + ks], Qf[ks], a, 0, 0, 0);
                st[4 * bt + tt] = a;
            }
            if (bt == 0) NA_LOADK(2);
            if (bt == 1) NA_LOADK(3);
            __builtin_amdgcn_sched_barrier(0);
        }
        bf16x8 VB[2][16];
        NA_LOADV(0); NA_LOADV(1);
        __builtin_amdgcn_sched_barrier(0);
        float mx = -1e30f;
#pragma unroll
        for (int t = 0; t < 16; ++t) {
            const int hf = t & 1;
#pragma unroll
            for (int e = 0; e < 4; ++e) {
                const int kcol = c0 + 8 * g + 4 * hf + e;
                const bool valid = (kcol >= cs) && (kcol < cs + 16);
                const float sc = valid ? st[t][e] : -1e30f;
                st[t][e] = sc; mx = fmaxf(mx, sc);
            }
        }
        mx = fmaxf(mx, shx(mx, 16, lane)); mx = fmaxf(mx, shx(mx, 32, lane));
        float sum = 0.f;
#pragma unroll
        for (int t = 0; t < 16; ++t)
#pragma unroll
            for (int e = 0; e < 4; ++e) { const float pv = fexp(st[t][e] - mx); st[t][e] = pv; sum += pv; }
        sum += shx(sum, 16, lane); sum += shx(sum, 32, lane);
        const float inv = 1.0f / sum;
        bf16x8 Pf[8];
#pragma unroll
        for (int kk = 0; kk < 8; ++kk) {
            u32x4 w; w.x = cvt_pk_bf16(st[2 * kk][0], st[2 * kk][1]); w.y = cvt_pk_bf16(st[2 * kk][2], st[2 * kk][3]);
            w.z = cvt_pk_bf16(st[2 * kk + 1][0], st[2 * kk + 1][1]); w.w = cvt_pk_bf16(st[2 * kk + 1][2], st[2 * kk + 1][3]);
            Pf[kk] = __builtin_bit_cast(bf16x8, w);
        }
        __builtin_amdgcn_sched_barrier(0);
#pragma unroll
        for (int vb = 0; vb < 4; ++vb) {
#pragma unroll
            for (int dd = 0; dd < 2; ++dd) {
                f32x4 O = (f32x4){0.f, 0.f, 0.f, 0.f};
#pragma unroll
                for (int kk = 0; kk < 8; ++kk) O = __builtin_amdgcn_mfma_f32_16x16x32_bf16(VB[vb & 1][dd * 8 + kk], Pf[kk], O, 0, 0, 0);
                u32x2 w; w.x = cvt_pk_bf16(O[0] * inv, O[1] * inv); w.y = cvt_pk_bf16(O[2] * inv, O[3] * inv);
                *(u32x2*)(ob + (size_t)tq * 1024 + hh * 128 + 16 * (2 * vb + dd) + 4 * g) = w;
            }
            if (vb == 0) NA_LOADV(2);
            if (vb == 1) NA_LOADV(3);
            __builtin_amdgcn_sched_barrier(0);
        }
#undef NA_LOADK
#undef NA_LOADV
    }
}

#define XB_TMO      128
#define XB_XCNT(j)  (256  + 64 * (j))
#define XB_XSUB(j)  (1280 + 64 * (j))
#define XB_XGEN(j)  (2304 + 64 * (j))
#define XB_TOP      3328
#define XB_TOPGEN   3392
#define XCD_BAR_WORDS 3456
#define XB_SPIN_CAP (1u << 22)
__device__ __forceinline__ unsigned xb_ld(unsigned* p)              { return __hip_atomic_load(p, __ATOMIC_RELAXED, __HIP_MEMORY_SCOPE_AGENT); }
__device__ __forceinline__ unsigned xb_add(unsigned* p, unsigned v) { return __hip_atomic_fetch_add(p, v, __ATOMIC_RELAXED, __HIP_MEMORY_SCOPE_AGENT); }
__device__ __forceinline__ unsigned xb_xcc_id() { return (unsigned)__builtin_amdgcn_s_getreg((3 << 11) | 20) & 0xFu; }
#define XB_SPIN(cond, bar) do { unsigned _sp = 0; while (cond) { __builtin_amdgcn_s_sleep(1); \
    if ((++_sp & 255u) == 0u) { if (xb_ld(&(bar)[XB_TMO])) break; if (_sp > XB_SPIN_CAP) { atomicAdd(&(bar)[XB_TMO], 1u); break; } } } } while (0)
struct XcdBarrier { unsigned* bar; unsigned x; volatile LAS unsigned* st; };
__device__ __forceinline__ XcdBarrier xcd_barrier_post(unsigned* bar, volatile LAS unsigned* st) {
    XcdBarrier b; b.bar = bar; b.x = xb_xcc_id(); b.st = st;
    if (threadIdx.x == 0) (void)xb_add(&bar[XB_XCNT(b.x)], 1u);
    return b;
}
__device__ __forceinline__ void xcd_barrier_complete(unsigned* bar, unsigned x, unsigned& nloc, unsigned& nx) {
    const unsigned G = gridDim.x * gridDim.y * gridDim.z;
    unsigned sum, cnt, mine, sp = 0u;
    for (;;) {
        sum = 0u; cnt = 0u; mine = 0u;
#pragma unroll
        for (unsigned j = 0; j < 16; ++j) { const unsigned c = xb_ld(&bar[XB_XCNT(j)]); sum += c; cnt += (c > 0u) ? 1u : 0u; mine = (j == x) ? c : mine; }
        if (sum == G) break;
        __builtin_amdgcn_s_sleep(1);
        if ((++sp & 255u) == 0u) { if (xb_ld(&bar[XB_TMO])) break; if (sp > XB_SPIN_CAP) { atomicAdd(&bar[XB_TMO], 1u); break; } }
    }
    nloc = mine > 0u ? mine : 1u; nx = cnt > 0u ? cnt : 1u;
}
__device__ __forceinline__ void xcd_barrier(const XcdBarrier& b) {
    asm volatile("s_waitcnt vmcnt(0)" ::: "memory");
    __syncthreads();
    if (threadIdx.x == 0) {
        unsigned* bar = b.bar;
        __builtin_amdgcn_s_waitcnt(0);
        unsigned nloc = b.st[0], nx = b.st[1];
        if (nloc == 0u) { xcd_barrier_complete(bar, b.x, nloc, nx); b.st[0] = nloc; b.st[1] = nx; }
        const unsigned old = xb_add(&bar[XB_XSUB(b.x)], 1u);
        const unsigned gen = old / nloc;
        if (old + 1u == (gen + 1u) * nloc) {
            __builtin_amdgcn_fence(__ATOMIC_RELEASE, "agent");
            asm volatile("s_waitcnt vmcnt(0)" ::: "memory");
            const unsigned og = xb_add(&bar[XB_TOP], 1u);
            const unsigned tg = og / nx;
            if (og + 1u == (tg + 1u) * nx) xb_add(&bar[XB_TOPGEN], 1u);
            else XB_SPIN(xb_ld(&bar[XB_TOPGEN]) == tg, bar);
            __builtin_amdgcn_fence(__ATOMIC_ACQUIRE, "agent");
            xb_add(&bar[XB_XGEN(b.x)], 1u);
            asm volatile("s_waitcnt vmcnt(0)" ::: "memory");
        } else {
            XB_SPIN(xb_ld(&bar[XB_XGEN(b.x)]) == gen, bar);
            __builtin_amdgcn_fence(__ATOMIC_ACQUIRE, "agent");
            asm volatile("s_waitcnt vmcnt(0)" ::: "memory");
        }
    }
    __syncthreads();
}

constexpr int NPH = 25, LDS_BYTES = 131072 + 16, NREC = 32;
#ifndef PHMASK
#define PHMASK 0xFFFF
#endif
#ifndef REPMASK
#define REPMASK 0
#endif
__global__ void __launch_bounds__(512, 2) mk_fwd(P p) {
    extern __shared__ __attribute__((aligned(16))) unsigned char shm[];
    LAS unsigned char* lds = (LAS unsigned char*)shm;
    volatile LAS unsigned* xbst = (volatile LAS unsigned*)(lds + 131072);
    if (threadIdx.x == 0) { xbst[0] = 0u; xbst[1] = 0u; xbst[2] = 0u; xbst[3] = 0u; }
    if (p.coop) {
        if (blockIdx.x == 0) { unsigned* bw = (unsigned*)(p.ws + OFF_BAR); for (int i = threadIdx.x; i < XCD_BAR_WORDS; i += 512) bw[i] = 0u; }
        asm volatile("s_waitcnt vmcnt(0) lgkmcnt(0)" ::: "memory");
        cg::this_grid().sync();
    }
    __syncthreads();
    const XcdBarrier xb = xcd_barrier_post((unsigned*)(p.ws + OFF_BAR), xbst);
    int rep = 0;
    for (int ph = p.ph_lo; ph < p.ph_hi;) {
        int tid = threadIdx.x, bid = blockIdx.x; unsigned long long zo = 0;
        asm volatile("" : "+v"(tid)); asm volatile("" : "+s"(bid)); asm volatile("" : "+s"(zo));
        unsigned char* ws = p.ws + zo;
        if (ph == 0) {
            {
                conv_A(p, ws, 0, lds, tid, bid);
                cvt_flat(p.x, (u16*)(ws + OFF_XB), (size_t)M_ * D_ / 4, tid, bid);
            }
        } else {
            const int l = (ph - 1) / 12, sp = (ph - 1) % 12;
            if (sp == 0 && (PHMASK & 1)) {
                Sched1 S{(const char*)(ws + OFF_XB), (const char*)(ws + OFF_WIN), 2048, 128, 32, 0, bid};
                EpiG1a E{(u16*)(ws + OFF_MIX), (u16*)(ws + OFF_VT), p.b_in + l * 12288, p.lbl, l};
                gemm_phase(lds, S, E, tid);
            } else if (sp == 1 && (PHMASK & 2)) {
                for (int item = bid; item < 256; item += (int)gridDim.x) rec1_phase(ws, lds, tid, item);
            } else if (sp == 2 && (PHMASK & 4)) {
                rec2_phase(ws, tid, bid);
                na_phase(p, ws, l, lds, 0, tid, bid);
            } else if (sp == 3 && (PHMASK & 8)) {
                rec3_phase(ws, lds, tid, bid);
            } else if (sp == 4 && (PHMASK & 16)) {
                post_phase(p, ws, l, tid, bid);
            } else if (sp == 5 && (PHMASK & 32)) {
                Sched1 S{(const char*)(ws + OFF_XB), (const char*)(ws + OFF_WIN), 2048, 128, 16, 32, bid};
                EpiG1b E{(u16*)(ws + OFF_GATES), p.b_in + l * 12288};
                gemm_phase(lds, S, E, tid);
            } else if (sp == 6 && (PHMASK & 64)) {
                Sched2 S{(const char*)(ws + OFF_OFW), (const char*)(ws + OFF_WBR), (const char*)(ws + OFF_OB), (const char*)(ws + OFF_WBR + 2048 * 1024 * 2), 1024, 1024, 128, 8, bid};
                EpiG3 E{(const u16*)(ws + OFF_GATES), (u16*)(ws + OFF_MERGED)};
                gemm_phase(lds, S, E, tid);
            } else if (sp == 7 && (PHMASK & 128)) {
                Sched1 S{(const char*)(ws + OFF_MERGED), (const char*)(ws + OFF_WOUT), 2048, 128, 8, 0, bid};
                if (l == 0) { EpiG4<0> E{p.x, p.out, (const float*)(ws + OFF_STATS), p.ln2g, p.ln2b}; gemm_phase(lds, S, E, tid); }
                else { EpiG4<1> E{p.out, p.out, (const float*)(ws + OFF_STATS), p.ln2g, p.ln2b}; gemm_phase(lds, S, E, tid); }
            } else if (sp == 8 && (PHMASK & 256)) {
                ln_phase<0>(p.out, p.ln1g + l * 2048, p.ln1b + l * 2048, (u16*)(ws + OFF_XB), (float*)(ws + OFF_STATS), tid, bid);
                __syncthreads();
                conv_B(p, ws, l, lds, tid, bid);
            } else if (sp == 9 && (PHMASK & 512)) {
                Sched1 S{(const char*)(ws + OFF_XB), (const char*)(ws + OFF_WUPG), 2048, 128, 52, 0, bid};
                EpiG6 E{(u16*)(ws + OFF_H), (u16*)(ws + OFF_SG)};
                gemm_phase(lds, S, E, tid);
            } else if (sp == 10 && (PHMASK & 1024)) {
                Sched2 S{(const char*)(ws + OFF_PB), (const char*)(ws + OFF_WPE), (const char*)(ws + OFF_H), (const char*)(ws + OFF_WDOWN), 256, FH, 128, 8, bid};
                EpiG7 E{(const u16*)(ws + OFF_SG), p.out, (const float*)(ws + OFF_STATS), p.ln1g + l * 2048, p.ln1b + l * 2048};
                gemm_phase(lds, S, E, tid);
            } else if (sp == 11 && (PHMASK & 2048)) {
                if (l == 0) ln_phase<0>(p.out, p.ln2g, p.ln2b, (u16*)(ws + OFF_XB), (float*)(ws + OFF_STATS), tid, bid);
                else ln_phase<1>(p.out, p.ln2g + 2048, p.ln2b + 2048, (u16*)(ws + OFF_XB), (float*)(ws + OFF_STATS), tid, bid);
                if (l == 0) { __syncthreads(); conv_A(p, ws, 1, lds, tid, bid); }
            }
        }
        if (REPMASK != 0 && ph > 0 && ((REPMASK >> ((ph - 1) % 12)) & 1) && rep == 0) rep = 1; else { rep = 0; ++ph; }
        if (ph < p.ph_hi) {
            if (p.coop) {
                xcd_barrier(xb);
            }
        }
        __syncthreads();
    }
}

extern "C" void kernel_launch(void* const* d_in, const int* in_sizes, int n_in, void* d_out, int out_size, void* d_ws, size_t ws_size, hipStream_t stream) {
    static int grid = 0;
    if (grid == 0) {
        if (ws_size < WS_END) { fprintf(stderr, "kernel_launch: workspace too small: %zu < %zu\n", ws_size, (size_t)WS_END); grid = -1; return; }
        if (hipFuncSetAttribute((const void*)mk_fwd, hipFuncAttributeMaxDynamicSharedMemorySize, LDS_BYTES) != hipSuccess) { fprintf(stderr, "kernel_launch: hipFuncSetAttribute failed\n"); grid = -1; return; }
        int dev = 0, cus = 0, per_cu = 0;
        hipGetDevice(&dev);
        hipDeviceGetAttribute(&cus, hipDeviceAttributeMultiprocessorCount, dev);
        if (hipOccupancyMaxActiveBlocksPerMultiprocessor(&per_cu, (const void*)mk_fwd, 512, LDS_BYTES) != hipSuccess || per_cu < 1) { fprintf(stderr, "kernel_launch: occupancy query failed (%d)\n", per_cu); (void)hipGetLastError(); per_cu = 1; }
        grid = cus * 1;
        if (grid < 64) { fprintf(stderr, "kernel_launch: unexpected CU count %d\n", cus); grid = -1; return; }
    }
    if (grid < 0) return;
    P p{};
    p.x = (const float*)d_in[0]; p.p = (const float*)d_in[1]; p.w_in = (const float*)d_in[2]; p.b_in = (const float*)d_in[3]; p.lbl = (const float*)d_in[4];
    p.ang = (const float*)d_in[5]; p.rpb = (const float*)d_in[6]; p.w_branch = (const float*)d_in[7]; p.w_out = (const float*)d_in[8];
    p.ln1g = (const float*)d_in[9]; p.ln1b = (const float*)d_in[10]; p.w_up = (const float*)d_in[11]; p.w_down = (const float*)d_in[12];
    p.w_pe = (const float*)d_in[13]; p.w_pg = (const float*)d_in[14]; p.ln2g = (const float*)d_in[15]; p.ln2b = (const float*)d_in[16];
    p.out = (float*)d_out; p.ws = (unsigned char*)d_ws; p.coop = 0; p.pad = 0;
    p.ph_lo = 0; p.ph_hi = NPH; p.coop = 1;
    if (hipMemsetAsync((char*)d_ws + OFF_BAR, 0, XCD_BAR_WORDS * 4, stream) != hipSuccess) { fprintf(stderr, "kernel_launch: hipMemsetAsync failed\n"); return; }
    void* args[] = {&p};
    hipError_t e = hipLaunchCooperativeKernel((const void*)mk_fwd, dim3(grid), dim3(512), args, LDS_BYTES, stream);
    if (e != hipSuccess) fprintf(stderr, "kernel_launch: cooperative launch failed: %s (grid %d)\n", hipGetErrorString(e), grid);
}
```

```cpp
#include <hip/hip_runtime.h>
#include <hip/hip_cooperative_groups.h>
#include <cstdio>
namespace cg = cooperative_groups;

#define LAS __attribute__((address_space(3)))
typedef unsigned short u16;
typedef short bf16x8 __attribute__((ext_vector_type(8)));
typedef short s16x4 __attribute__((ext_vector_type(4)));
typedef float f32x4 __attribute__((ext_vector_type(4)));
typedef float f32x16 __attribute__((ext_vector_type(16)));
typedef unsigned u32x4 __attribute__((ext_vector_type(4)));
typedef unsigned u32x2 __attribute__((ext_vector_type(2)));

constexpr int M_ = 32768, D_ = 2048, S_ = 16384, NMIX = 8192, FH = 5632;
constexpr float ALPHA = 1.41421356237f;

constexpr size_t OFF_XB = 0;
constexpr size_t OFF_WIN = 134217728;
constexpr size_t OFF_WBR = OFF_WIN + 50331648;
constexpr size_t OFF_WOUT = OFF_WBR + 8388608;
constexpr size_t OFF_MIX = 201326592;
constexpr size_t OFF_VT = 738197504;
constexpr size_t OFF_OFW = 805306368;
constexpr size_t OFF_OBW = 872415232;
constexpr size_t OFF_OB = 939524096;
constexpr size_t OFF_SGRP = 1006632960;
constexpr size_t OFF_SINT = OFF_SGRP + 16777216;
constexpr size_t OFF_GPRE = OFF_SINT + 8388608;
constexpr size_t OFF_GTOT = OFF_GPRE + 4194304;
constexpr size_t OFF_BAR = OFF_GTOT + 131072;
constexpr size_t OFF_STATS = OFF_BAR + 16384;
constexpr size_t WS_END = OFF_STATS + 262144;
constexpr size_t OFF_GATES = OFF_MIX;
constexpr size_t OFF_MERGED = OFF_MIX + 268435456;
constexpr size_t OFF_H = OFF_MIX;
constexpr size_t OFF_SG = OFF_MIX + 369098752;
constexpr size_t OFF_WUPG = OFF_OFW;
constexpr size_t OFF_WDOWN = OFF_WUPG + 54525952;
constexpr size_t OFF_WPE = OFF_WDOWN + 23068672;
constexpr size_t OFF_PB = OFF_WPE + 1048576;

struct P {
    const float *x, *p, *w_in, *b_in, *lbl, *ang, *rpb, *w_branch, *w_out, *ln1g, *ln1b, *w_up, *w_down, *w_pe, *w_pg, *ln2g, *ln2b;
    float* out; unsigned char* ws; int ph_lo, ph_hi, coop, pad;
};

typedef __bf16 bf16v2 __attribute__((ext_vector_type(2)));
typedef float f32x2 __attribute__((ext_vector_type(2)));
__device__ __forceinline__ unsigned cvt_pk_bf16(float lo, float hi) { f32x2 f = {lo, hi}; bf16v2 b = __builtin_convertvector(f, bf16v2); return __builtin_bit_cast(unsigned, b); }
__device__ __forceinline__ float shx(float v, int o, int lane) { return __int_as_float(__builtin_amdgcn_ds_bpermute((lane ^ o) << 2, __float_as_int(v))); }
__device__ __forceinline__ float bf_lo(unsigned w) { return __uint_as_float(w << 16); }
__device__ __forceinline__ float bf_hi(unsigned w) { return __uint_as_float(w & 0xffff0000u); }
__device__ __forceinline__ float bf2f(u16 b) { return __uint_as_float(((unsigned)b) << 16); }
__device__ __forceinline__ u16 f2bf(float f) { return (u16)(cvt_pk_bf16(f, 0.f) & 0xffffu); }
__device__ __forceinline__ float fexp(float v) { return __builtin_amdgcn_exp2f(v * 1.44269504089f); }
__device__ __forceinline__ float sigm(float v) { return __builtin_amdgcn_rcpf(1.0f + fexp(-v)); }
__device__ __forceinline__ float silu(float v) { return v * sigm(v); }
__device__ __forceinline__ u16 f2h(float f) { _Float16 h = (_Float16)f; return __builtin_bit_cast(u16, h); }
__device__ __forceinline__ float h2f(u16 b) { return (float)__builtin_bit_cast(_Float16, b); }

constexpr int BM = 256, BK = 64, HALF = 128, HTB = HALF * BK * 2, NXCD = 8, WGM = 8;
__device__ __forceinline__ int lds_byte(int r, int c) { const int st = (r >> 4) * 2 + (c >> 5), rr = r & 15, cc = c & 31, ob = rr * 64 + cc * 2; return st * 1024 + (ob ^ (((ob >> 9) & 1) << 5)); }
__device__ __forceinline__ void stage_rc(int b, int& R, int& C) { const int st = b / 1024, sb = b % 1024, swz = sb ^ (((sb >> 9) & 1) << 5); R = (st >> 1) * 16 + swz / 64; C = (st & 1) * 32 + (swz % 64) / 2; }

struct Unit { const char* A; const char* B; int K; int pm, pn, seg, fin; };

__device__ __forceinline__ void tile_of(int L, int nM, int nN, int& pm, int& pn) {
    const int nwg = nM * nN; int wgid = L;
    { const int q = nwg / NXCD, r = nwg % NXCD, xcd = wgid % NXCD, off = wgid / NXCD; wgid = (xcd < r ? xcd * (q + 1) : r * (q + 1) + (xcd - r) * q) + off; }
    const int nig = WGM * nN, gid = wgid / nig, fm = gid * WGM, gsz = (nM - fm) < WGM ? (nM - fm) : WGM;
    pm = fm + ((wgid % nig) % gsz); pn = (wgid % nig) / gsz;
}
struct Sched1 {
    const char* A; const char* B; int K, nM, nN, pn0, bid;
    __device__ __forceinline__ bool next(int i, Unit& u) const {
        const int L = i * (int)gridDim.x + bid; if (L >= nM * nN) return false;
        tile_of(L, nM, nN, u.pm, u.pn);
        u.A = A + (size_t)u.pm * 256 * K * 2; u.B = B + (size_t)(u.pn + pn0) * 256 * K * 2; u.K = K; u.seg = 0; u.fin = 1; return true;
    }
};
struct Sched2 {
    const char *A0, *B0, *A1, *B1; int K0, K1, nM, nN, bid;
    __device__ __forceinline__ bool next(int i, Unit& u) const {
        const int L = (i >> 1) * (int)gridDim.x + bid; if (L >= nM * nN) return false;
        tile_of(L, nM, nN, u.pm, u.pn); const int sg = i & 1; const int K = sg ? K1 : K0;
        u.A = (sg ? A1 : A0) + (size_t)u.pm * 256 * K * 2; u.B = (sg ? B1 : B0) + (size_t)u.pn * 256 * K * 2; u.K = K; u.seg = sg; u.fin = sg; return true;
    }
};

template <class Sched, class Epi>
__device__ __forceinline__ void gemm_phase(LAS unsigned char* lds, const Sched& S, const Epi& E, const int tid) {
    const int wid = __builtin_amdgcn_readfirstlane(tid >> 6), lane = tid & 63, wr = wid >> 2, wc = wid & 3, fr = lane & 15, fq = lane >> 4;
    int RR0, C20;
    { int R, C; stage_rc(tid * 16, R, C); RR0 = R; C20 = C * 2; }
    const size_t kstep = (size_t)(BK * 2);
    const unsigned ldsw = (unsigned)wid * 1024u;
    const int aoff = lds_byte(wr * 64 + fr, fq * 8), boff = lds_byte(wc * 32 + fr, fq * 8);
#define G_SA(b, h) (((b) * 2 + (h)) * HTB)
#define G_SB(b, h) ((4 + (b) * 2 + (h)) * HTB)
#define G_STAGE(bufoff, gbase, ld2) do { _Pragma("unroll") for (int _i = 0; _i < 2; ++_i) \
        __builtin_amdgcn_global_load_lds((const unsigned*)((const char*)(gbase) + (unsigned)((RR0 + 64 * _i) * (ld2) + C20)), (LAS unsigned*)(lds + (bufoff) + ldsw + _i * 8192), 16, 0, 0); } while (0)
#define G_LDA(dst, b, h) do { _Pragma("unroll") for (int m = 0; m < 4; ++m) _Pragma("unroll") for (int k = 0; k < 2; ++k) dst[m][k] = *(const LAS bf16x8*)(lds + G_SA(b, h) + aoff + m * 2048 + k * 1024); } while (0)
#define G_LDB(dst, b, h) do { _Pragma("unroll") for (int n = 0; n < 2; ++n) _Pragma("unroll") for (int k = 0; k < 2; ++k) dst[n][k] = *(const LAS bf16x8*)(lds + G_SB(b, h) + boff + n * 2048 + k * 1024); } while (0)
#define G_MMA(ai, bj, At, Bt) do { __builtin_amdgcn_s_setprio(1); _Pragma("unroll") for (int m = 0; m < 4; ++m) _Pragma("unroll") for (int n = 0; n < 2; ++n) _Pragma("unroll") for (int k = 0; k < 2; ++k) \
        acc[ai][bj][m][n] = __builtin_amdgcn_mfma_f32_16x16x32_bf16(Bt[n][k], At[m][k], acc[ai][bj][m][n], 0, 0, 0); __builtin_amdgcn_s_setprio(0); } while (0)
#define G_WAIT_V(n) asm volatile("s_waitcnt vmcnt(" #n ")" ::: "memory")
#define G_WAIT_L(n) asm volatile("s_waitcnt lgkmcnt(" #n ")" ::: "memory")
#define G_BAR __builtin_amdgcn_s_barrier()
#define G_SCHED __builtin_amdgcn_sched_barrier(0)
    Unit cur, nxt; int ui = 0;
    if (!S.next(0, cur)) return;
    f32x4 acc[2][2][4][2];
#pragma unroll
    for (int a = 0; a < 2; ++a)
#pragma unroll
        for (int b = 0; b < 2; ++b)
#pragma unroll
            for (int m = 0; m < 4; ++m)
#pragma unroll
                for (int n = 0; n < 2; ++n) acc[a][b][m][n] = (f32x4){0.f, 0.f, 0.f, 0.f};
    bf16x8 At[4][2], B0[2][2], B1[2][2];
    const char* cA = cur.A; const char* cB = cur.B;
    {
        const int ld2 = cur.K * 2; const size_t hstep = (size_t)HALF * ld2;
        G_STAGE(G_SB(0, 0), cB, ld2); G_STAGE(G_SA(0, 0), cA, ld2); G_STAGE(G_SB(0, 1), cB + hstep, ld2); G_STAGE(G_SA(0, 1), cA + hstep, ld2);
        if (wr == 1) G_BAR;
        G_WAIT_V(4); G_BAR;
        G_STAGE(G_SB(1, 0), cB + kstep, ld2); G_STAGE(G_SA(1, 0), cA + kstep, ld2); G_STAGE(G_SB(1, 1), cB + hstep + kstep, ld2);
        G_WAIT_V(6); G_BAR;
    }
    for (;;) {
        const bool has_next = S.next(ui + 1, nxt);
        const char* nA = has_next ? nxt.A : cA; const char* nB = has_next ? nxt.B : cB;
        const int ld2c = cur.K * 2, ld2n = has_next ? nxt.K * 2 : ld2c;
        const size_t hstepc = (size_t)HALF * ld2c;
        const int nt = cur.K / BK;
        for (int t = 0; t < nt; t += 2) {
            const bool last = (t == nt - 2);
            const char* a1 = cA + (size_t)(t + 1) * kstep;
            const char* a2 = last ? nA : cA + (size_t)(t + 2) * kstep; const char* b2 = last ? nB : cB + (size_t)(t + 2) * kstep;
            const int ld2x = last ? ld2n : ld2c; const size_t hstepx = (size_t)HALF * ld2x;
            const char* a3 = a2 + kstep; const char* b3 = b2 + kstep;
            G_LDB(B0, 0, 0); G_SCHED; G_LDA(At, 0, 0); G_STAGE(G_SA(1, 1), a1 + hstepc, ld2c);
            G_WAIT_L(8); G_BAR; G_WAIT_L(0); G_MMA(0, 0, At, B0); G_BAR; G_SCHED;
            G_LDB(B1, 0, 1); G_STAGE(G_SB(0, 0), b2, ld2x);
            G_BAR; G_WAIT_L(0); G_MMA(0, 1, At, B1); G_BAR;
            G_LDA(At, 0, 1); G_STAGE(G_SA(0, 0), a2, ld2x);
            G_BAR; G_WAIT_L(0); G_MMA(1, 0, At, B0); G_BAR; G_SCHED;
            G_STAGE(G_SB(0, 1), b2 + hstepx, ld2x);
            G_WAIT_V(6); G_BAR; G_MMA(1, 1, At, B1); G_BAR;
            G_LDB(B0, 1, 0); G_SCHED; G_LDA(At, 1, 0); G_STAGE(G_SA(0, 1), a2 + hstepx, ld2x);
            G_WAIT_L(8); G_BAR; G_WAIT_L(0); G_MMA(0, 0, At, B0); G_BAR; G_SCHED;
            G_LDB(B1, 1, 1); G_STAGE(G_SB(1, 0), b3, ld2x);
            G_BAR; G_WAIT_L(0); G_MMA(0, 1, At, B1); G_BAR;
            G_LDA(At, 1, 1); G_STAGE(G_SA(1, 0), a3, ld2x);
            G_BAR; G_WAIT_L(0); G_MMA(1, 0, At, B0); G_BAR; G_SCHED;
            G_STAGE(G_SB(1, 1), b3 + hstepx, ld2x);
            G_WAIT_V(6); G_BAR; G_MMA(1, 1, At, B1); G_BAR;
        }
        E(acc, cur, wr, wc, fr, fq);
        if (!has_next) break;
        if (cur.fin) {
#pragma unroll
            for (int a = 0; a < 2; ++a)
#pragma unroll
                for (int b = 0; b < 2; ++b)
#pragma unroll
                    for (int m = 0; m < 4; ++m)
#pragma unroll
                        for (int n = 0; n < 2; ++n) acc[a][b][m][n] = (f32x4){0.f, 0.f, 0.f, 0.f};
        }
        cur = nxt; cA = nA; cB = nB; ++ui;
    }
    G_WAIT_V(0);
    if (wr == 0) G_BAR;
    G_BAR;
#undef G_SA
#undef G_SB
#undef G_STAGE
#undef G_LDA
#undef G_LDB
#undef G_MMA
}

#define EPI_LOOP_BN _Pragma("unroll") for (int bj = 0; bj < 2; ++bj) _Pragma("unroll") for (int n = 0; n < 2; ++n)
#define EPI_LOOP_AM _Pragma("unroll") for (int ai = 0; ai < 2; ++ai) _Pragma("unroll") for (int m = 0; m < 4; ++m)

__device__ __forceinline__ u32x4 pack8(const f32x4 a, const f32x4 b) { u32x4 w; w.x = cvt_pk_bf16(a[0], a[1]); w.y = cvt_pk_bf16(a[2], a[3]); w.z = cvt_pk_bf16(b[0], b[1]); w.w = cvt_pk_bf16(b[2], b[3]); return w; }
#define EPI_LOOP_B _Pragma("unroll") for (int bj = 0; bj < 2; ++bj)
#define EPI_LOOP_N _Pragma("unroll") for (int n = 0; n < 2; ++n)

struct EpiG1a {
    u16* mix; u16* vT; const float* bias; const float* lbl; int layer;
    __device__ __forceinline__ void operator()(f32x4 (&acc)[2][2][4][2], const Unit& u, int wr, int wc, int fr, int fq) const {
        const int type = u.pn >> 2;
        const int row0 = u.pm * 256 + wr * 64 + fr, colb = u.pn * 256 + wc * 32 + 8 * fq;
        f32x4 bvh[2][2], lbh[2][2];
        EPI_LOOP_B { EPI_LOOP_N { bvh[bj][n] = *(const f32x4*)(bias + colb + bj * 128 + 4 * n); lbh[bj][n] = (f32x4){0.f, 0.f, 0.f, 0.f}; } }
        if ((type == 3 || type == 4) && layer == 1) {
            const int dir = type - 3;
            EPI_LOOP_B { EPI_LOOP_N {
                const int cc = colb + bj * 128 - 3072 - dir * 1024 + 4 * n;
                const f32x4 l0 = *(const f32x4*)(lbl + dir * 1024 + cc), l1 = *(const f32x4*)(lbl + (2 + dir) * 1024 + cc);
#pragma unroll
                for (int e = 0; e < 4; ++e) lbh[bj][n][e] = sigm(l1[e] - l0[e]);
            } }
        }
        EPI_LOOP_B {
            const int c8 = colb + bj * 128;
            f32x4 bv[2], lb[2];
            EPI_LOOP_N { bv[n] = bvh[bj][n]; lb[n] = lbh[bj][n]; }
            EPI_LOOP_AM {
                const int r = row0 + ai * 128 + m * 16;
                f32x4 v[2];
                EPI_LOOP_N v[n] = acc[ai][bj][m][n] + bv[n];
                if (type == 7) {
                    const int b = r >> 14, s = r & 16383, hd = c8 - 7168;
                    EPI_LOOP_N {
#pragma unroll
                        for (int e = 0; e < 4; ++e) vT[((size_t)(b * 1024 + hd + 4 * n + e)) * 16384 + s] = f2bf(v[n][e]);
                    }
                } else {
                    u32x4 w;
                    if (type == 3 || type == 4) {
                        unsigned hw[2][2];
                        EPI_LOOP_N {
                            float o[4];
#pragma unroll
                            for (int e = 0; e < 4; ++e) { float f = lb[n][e] + (1.0f - lb[n][e]) * sigm(v[n][e]); f = fminf(fmaxf(f, 1e-6f), 1.0f); o[e] = __builtin_amdgcn_logf(f) * 0.69314718056f; }
                            hw[n][0] = (unsigned)f2h(o[0]) | ((unsigned)f2h(o[1]) << 16); hw[n][1] = (unsigned)f2h(o[2]) | ((unsigned)f2h(o[3]) << 16);
                        }
                        w.x = hw[0][0]; w.y = hw[0][1]; w.z = hw[1][0]; w.w = hw[1][1];
                    } else {
                        if (type == 0 || type == 2) {
                            EPI_LOOP_N {
#pragma unroll
                                for (int e = 0; e < 4; ++e) v[n][e] = silu(v[n][e]);
                            }
                        } else if (type == 5) { v[0] = v[0] * 0.08838834764831845f; v[1] = v[1] * 0.08838834764831845f; }
                        w = pack8(v[0], v[1]);
                    }
                    *(u32x4*)(mix + (size_t)r * NMIX + c8) = w;
                }
            }
        }
    }
};
struct EpiG1b {
    u16* gates; const float* bias;
    __device__ __forceinline__ void operator()(f32x4 (&acc)[2][2][4][2], const Unit& u, int wr, int wc, int fr, int fq) const {
        const int row0 = u.pm * 256 + wr * 64 + fr, colb = u.pn * 256 + wc * 32 + 8 * fq;
        f32x4 bvh[2][2];
        EPI_LOOP_B { EPI_LOOP_N bvh[bj][n] = *(const f32x4*)(bias + 8192 + colb + bj * 128 + 4 * n); }
        EPI_LOOP_B {
            const int c8 = colb + bj * 128;
            const f32x4 bv0 = bvh[bj][0], bv1 = bvh[bj][1];
            EPI_LOOP_AM {
                const int r = row0 + ai * 128 + m * 16;
                f32x4 v0 = acc[ai][bj][m][0] + bv0, v1 = acc[ai][bj][m][1] + bv1;
#pragma unroll
                for (int e = 0; e < 4; ++e) { v0[e] = sigm(v0[e]); v1[e] = sigm(v1[e]); }
                *(u32x4*)(gates + (size_t)r * 4096 + c8) = pack8(v0, v1);
            }
        }
    }
};
struct EpiG3 {
    const u16* gates; u16* merged;
    __device__ __forceinline__ void operator()(f32x4 (&acc)[2][2][4][2], const Unit& u, int wr, int wc, int fr, int fq) const {
        const int row0 = u.pm * 256 + wr * 64 + fr, colb = u.pn * 256 + wc * 32 + 8 * fq;
        EPI_LOOP_B {
            const int c8 = colb + bj * 128;
#pragma unroll
            for (int ai = 0; ai < 2; ++ai) {
                u32x4 gbw[4], gaw[4];
#pragma unroll
                for (int m = 0; m < 4; ++m) { const int r = row0 + ai * 128 + m * 16; gbw[m] = *(const u32x4*)(gates + (size_t)r * 4096 + 2048 + c8); }
                if (u.seg == 0) {
#pragma unroll
                    for (int m = 0; m < 4; ++m) { const int r = row0 + ai * 128 + m * 16; gaw[m] = *(const u32x4*)(gates + (size_t)r * 4096 + c8); }
#pragma unroll
                    for (int m = 0; m < 4; ++m) {
                        EPI_LOOP_N {
                            f32x4 v = acc[ai][bj][m][n];
                            v[0] *= bf_lo(gaw[m][2 * n]) * __builtin_amdgcn_rcpf(bf_lo(gbw[m][2 * n])); v[1] *= bf_hi(gaw[m][2 * n]) * __builtin_amdgcn_rcpf(bf_hi(gbw[m][2 * n]));
                            v[2] *= bf_lo(gaw[m][2 * n + 1]) * __builtin_amdgcn_rcpf(bf_lo(gbw[m][2 * n + 1])); v[3] *= bf_hi(gaw[m][2 * n + 1]) * __builtin_amdgcn_rcpf(bf_hi(gbw[m][2 * n + 1]));
                            acc[ai][bj][m][n] = v;
                        }
                    }
                } else {
#pragma unroll
                    for (int m = 0; m < 4; ++m) {
                        const int r = row0 + ai * 128 + m * 16;
                        f32x4 v[2];
                        EPI_LOOP_N { v[n] = acc[ai][bj][m][n]; v[n][0] *= bf_lo(gbw[m][2 * n]); v[n][1] *= bf_hi(gbw[m][2 * n]); v[n][2] *= bf_lo(gbw[m][2 * n + 1]); v[n][3] *= bf_hi(gbw[m][2 * n + 1]); }
                        *(u32x4*)(merged + (size_t)r * 2048 + c8) = pack8(v[0], v[1]);
                    }
                }
            }
        }
    }
};
template <int LN> struct EpiG4 {
    const float* xres; float* y; const float* stats; const float* g; const float* b;
    __device__ __forceinline__ void operator()(f32x4 (&acc)[2][2][4][2], const Unit& u, int wr, int wc, int fr, int fq) const {
        const int row0 = u.pm * 256 + wr * 64 + fr, colb = u.pn * 256 + wc * 32 + 8 * fq;
        f32x4 xr[2][4], gv[2], bv[2]; f32x2 st[2][4];
#define G4_LOAD(k) do { const int ai_ = (k) >> 2, c_ = colb + (((k) >> 1) & 1) * 128 + 4 * ((k) & 1); \
            if (LN) { gv[(k) & 1] = *(const f32x4*)(g + c_); bv[(k) & 1] = *(const f32x4*)(b + c_); } \
            _Pragma("unroll") for (int m = 0; m < 4; ++m) { const int r_ = row0 + ai_ * 128 + m * 16; xr[(k) & 1][m] = *(const f32x4*)(xres + (size_t)r_ * 2048 + c_); \
                if (LN) st[(k) & 1][m] = *(const f32x2*)(stats + 2 * r_); } } while (0)
        G4_LOAD(0);
#pragma unroll
        for (int k = 0; k < 8; ++k) {
            if (k < 7) G4_LOAD(k + 1);
            const int ai = k >> 2, bj = (k >> 1) & 1, n = k & 1, c = colb + bj * 128 + 4 * n;
#pragma unroll
            for (int m = 0; m < 4; ++m) {
                f32x4 x = xr[k & 1][m];
                if (LN) x = (x - st[k & 1][m][0]) * st[k & 1][m][1] * gv[k & 1] + bv[k & 1];
                *(f32x4*)(y + (size_t)(row0 + ai * 128 + m * 16) * 2048 + c) = x * ALPHA + acc[ai][bj][m][n];
            }
        }
#undef G4_LOAD
    }
};
struct EpiG6 {
    u16* h; u16* sg;
    __device__ __forceinline__ void operator()(f32x4 (&acc)[2][2][4][2], const Unit& u, int wr, int wc, int fr, int fq) const {
        const int row0 = u.pm * 256 + wr * 64 + fr;
        if (u.pn < 44) {
            const int hc = u.pn * 128 + wc * 32 + 8 * fq;
            EPI_LOOP_AM {
                const int r = row0 + ai * 128 + m * 16;
                f32x4 o0, o1;
#pragma unroll
                for (int e = 0; e < 4; ++e) { o0[e] = silu(acc[ai][0][m][0][e]) * acc[ai][0][m][1][e]; o1[e] = silu(acc[ai][1][m][0][e]) * acc[ai][1][m][1][e]; }
                *(u32x4*)(h + (size_t)r * FH + hc) = pack8(o0, o1);
            }
        } else {
            const int colb = (u.pn - 44) * 256 + wc * 32 + 8 * fq;
            EPI_LOOP_B {
                const int c8 = colb + bj * 128;
                EPI_LOOP_AM {
                    const int r = row0 + ai * 128 + m * 16;
                    f32x4 v0 = acc[ai][bj][m][0], v1 = acc[ai][bj][m][1];
#pragma unroll
                    for (int e = 0; e < 4; ++e) { v0[e] = sigm(v0[e]); v1[e] = sigm(v1[e]); }
                    *(u32x4*)(sg + (size_t)r * 2048 + c8) = pack8(v0, v1);
                }
            }
        }
    }
};
struct EpiG7 {
    const u16* sg; float* y; const float* stats; const float* g; const float* b;
    __device__ __forceinline__ void operator()(f32x4 (&acc)[2][2][4][2], const Unit& u, int wr, int wc, int fr, int fq) const {
        const int row0 = u.pm * 256 + wr * 64 + fr, colb = u.pn * 256 + wc * 32 + 8 * fq;
        if (u.seg == 0) {
            EPI_LOOP_B {
                const int c8 = colb + bj * 128;
                u32x4 sv[2][4];
                EPI_LOOP_AM { const int r = row0 + ai * 128 + m * 16; sv[ai][m] = *(const u32x4*)(sg + (size_t)r * 2048 + c8); }
                EPI_LOOP_AM {
                    EPI_LOOP_N {
                        f32x4 v = acc[ai][bj][m][n];
                        v[0] *= bf_lo(sv[ai][m][2 * n]); v[1] *= bf_hi(sv[ai][m][2 * n]); v[2] *= bf_lo(sv[ai][m][2 * n + 1]); v[3] *= bf_hi(sv[ai][m][2 * n + 1]);
                        acc[ai][bj][m][n] = v;
                    }
                }
            }
        } else {
#pragma unroll
            for (int ai = 0; ai < 2; ++ai) {
                f32x2 st[4];
#pragma unroll
                for (int m = 0; m < 4; ++m) st[m] = *(const f32x2*)(stats + 2 * (row0 + ai * 128 + m * 16));
                EPI_LOOP_BN {
                    const int c = colb + bj * 128 + 4 * n;
                    const f32x4 gv = *(const f32x4*)(g + c), bv = *(const f32x4*)(b + c);
                    f32x4 xr[4];
#pragma unroll
                    for (int m = 0; m < 4; ++m) xr[m] = *(const f32x4*)(y + (size_t)(row0 + ai * 128 + m * 16) * 2048 + c);
#pragma unroll
                    for (int m = 0; m < 4; ++m) {
                        const f32x4 x1 = (xr[m] - st[m][0]) * st[m][1] * gv + bv;
                        *(f32x4*)(y + (size_t)(row0 + ai * 128 + m * 16) * 2048 + c) = x1 * ALPHA + acc[ai][bj][m][n];
                    }
                }
            }
        }
    }
};

template <int PERM>
__device__ __forceinline__ void convT(const float* src, int ldsrc, int K, int N, u16* dst, LAS float* tl, const int tid, const int bid) {
    const int nkt = K >> 6, nnt = N >> 7;
    for (int T = bid; T < nkt * nnt; T += gridDim.x) {
        const int kt = T % nkt, ntile = T / nkt; const int k0 = kt << 6, n0 = ntile << 7;
        const int nn = tid & 127; const int rho = n0 + nn;
        int sc;
        if (PERM) { const int R = rho & 255; const int j = (rho >> 8) * 128 + 32 * ((R >> 5) & 3) + 8 * ((R >> 2) & 3) + 4 * (R >> 7) + (R & 3); sc = ((R >> 4) & 1) ? FH + j : j; }
        else { const int q = rho & 31; sc = (rho & ~31) + 8 * ((q & 15) >> 2) + 4 * (q >> 4) + (q & 3); }
        float ld[16];
#pragma unroll
        for (int i = 0; i < 16; ++i) ld[i] = src[(size_t)(k0 + (tid >> 7) + 4 * i) * ldsrc + sc];
#pragma unroll
        for (int i = 0; i < 16; ++i) tl[((tid >> 7) + 4 * i) * 129 + nn] = ld[i];
        __syncthreads();
        const int n2 = tid >> 2, k16 = (tid & 3) << 4;
        float v[16];
#pragma unroll
        for (int j = 0; j < 16; ++j) v[j] = tl[(k16 + j) * 129 + n2];
        u32x4 w0, w1;
#pragma unroll
        for (int j = 0; j < 4; ++j) { w0[j] = cvt_pk_bf16(v[2 * j], v[2 * j + 1]); w1[j] = cvt_pk_bf16(v[8 + 2 * j], v[9 + 2 * j]); }
        u16* dp = dst + (size_t)(n0 + n2) * K + k0 + k16;
        *(u32x4*)dp = w0; *(u32x4*)(dp + 8) = w1;
        __syncthreads();
    }
}
__device__ __forceinline__ void cvt_flat(const float* src, u16* dst, size_t n4, const int tid, const int bid) {
    const size_t stride = (size_t)gridDim.x * 512;
    size_t i = (size_t)bid * 512 + tid;
    for (; i + 3 * stride < n4; i += 4 * stride) {
        f32x4 v[4];
#pragma unroll
        for (int j = 0; j < 4; ++j) v[j] = *(const f32x4*)(src + (i + j * stride) * 4);
#pragma unroll
        for (int j = 0; j < 4; ++j) { u32x2 w; w.x = cvt_pk_bf16(v[j][0], v[j][1]); w.y = cvt_pk_bf16(v[j][2], v[j][3]); *(u32x2*)(dst + (i + j * stride) * 4) = w; }
    }
    for (; i < n4; i += stride) {
        const f32x4 v = *(const f32x4*)(src + i * 4);
        u32x2 w; w.x = cvt_pk_bf16(v[0], v[1]); w.y = cvt_pk_bf16(v[2], v[3]);
        *(u32x2*)(dst + i * 4) = w;
    }
}
__device__ __forceinline__ void conv_A(const P& p, unsigned char* ws, int l, LAS unsigned char* lds, const int tid, const int bid) {
    LAS float* tl = (LAS float*)lds;
    convT<0>(p.w_in + (size_t)l * 2048 * 12288, 12288, 2048, 12288, (u16*)(ws + OFF_WIN), tl, tid, bid);
    convT<0>(p.w_branch + (size_t)(l * 2 + 0) * 1024 * 2048, 2048, 1024, 2048, (u16*)(ws + OFF_WBR), tl, tid, bid);
    convT<0>(p.w_branch + (size_t)(l * 2 + 1) * 1024 * 2048, 2048, 1024, 2048, (u16*)(ws + OFF_WBR) + 2048 * 1024, tl, tid, bid);
    convT<0>(p.w_out + (size_t)l * 2048 * 2048, 2048, 2048, 2048, (u16*)(ws + OFF_WOUT), tl, tid, bid);
}
__device__ __forceinline__ void conv_B(const P& p, unsigned char* ws, int l, LAS unsigned char* lds, const int tid, const int bid) {
    LAS float* tl = (LAS float*)lds;
    convT<1>(p.w_up + (size_t)l * 2048 * 11264, 11264, 2048, 11264, (u16*)(ws + OFF_WUPG), tl, tid, bid);
    convT<0>(p.w_pg + (size_t)l * 2048 * 2048, 2048, 2048, 2048, (u16*)(ws + OFF_WUPG) + (size_t)11264 * 2048, tl, tid, bid);
    convT<0>(p.w_down + (size_t)l * FH * 2048, 2048, FH, 2048, (u16*)(ws + OFF_WDOWN), tl, tid, bid);
    convT<0>(p.w_pe + (size_t)l * 256 * 2048, 2048, 256, 2048, (u16*)(ws + OFF_WPE), tl, tid, bid);
    cvt_flat(p.p + (size_t)l * M_ * 256, (u16*)(ws + OFF_PB), (size_t)M_ * 256 / 4, tid, bid);
}

template <int FULL>
__device__ __forceinline__ void ln_phase(float* y, const float* g, const float* b, u16* xb, float* stats, const int tid, const int bid) {
    constexpr int NR = 4;
    const int lane = tid & 63, wid = tid >> 6;
    const int nw = (int)gridDim.x * 8;
    for (int row0 = bid * 8 + wid; row0 < M_; row0 += NR * nw) {
        f32x4 v[NR][8]; float s[NR], q[NR];
#pragma unroll
        for (int k = 0; k < NR; ++k) { const int row = min(row0 + k * nw, M_ - 1); const float* yp = y + (size_t)row * 2048 + lane * 4;
#pragma unroll
            for (int i = 0; i < 8; ++i) v[k][i] = *(const f32x4*)(yp + i * 256); }
#pragma unroll
        for (int k = 0; k < NR; ++k) { s[k] = 0.f;
#pragma unroll
            for (int i = 0; i < 8; ++i) s[k] += (v[k][i][0] + v[k][i][1]) + (v[k][i][2] + v[k][i][3]); }
#pragma unroll
        for (int o = 32; o >= 1; o >>= 1)
#pragma unroll
            for (int k = 0; k < NR; ++k) s[k] += shx(s[k], o, lane);
#pragma unroll
        for (int k = 0; k < NR; ++k) { s[k] *= (1.0f / 2048.0f); q[k] = 0.f;
#pragma unroll
            for (int i = 0; i < 8; ++i) { const f32x4 d = v[k][i] - s[k]; q[k] += (d[0] * d[0] + d[1] * d[1]) + (d[2] * d[2] + d[3] * d[3]); } }
#pragma unroll
        for (int o = 32; o >= 1; o >>= 1)
#pragma unroll
            for (int k = 0; k < NR; ++k) q[k] += shx(q[k], o, lane);
#pragma unroll
        for (int k = 0; k < NR; ++k) q[k] = rsqrtf(q[k] * (1.0f / 2048.0f) + 1e-5f);
#pragma unroll
        for (int i = 0; i < 8; ++i) {
            const f32x4 gv = *(const f32x4*)(g + i * 256 + lane * 4), bv = *(const f32x4*)(b + i * 256 + lane * 4);
#pragma unroll
            for (int k = 0; k < NR; ++k) {
                const int row = row0 + k * nw;
                if (row < M_) {
                    const f32x4 o = (v[k][i] - s[k]) * q[k] * gv + bv;
                    if (FULL) *(f32x4*)(y + (size_t)row * 2048 + lane * 4 + i * 256) = o;
                    else if (i == 0 && lane == 0) *(f32x2*)(stats + 2 * row) = (f32x2){s[k], q[k]};
                    u32x2 w; w.x = cvt_pk_bf16(o[0], o[1]); w.y = cvt_pk_bf16(o[2], o[3]);
                    *(u32x2*)(xb + (size_t)row * 2048 + i * 256 + lane * 4) = w;
                }
            }
        }
    }
}

__device__ __forceinline__ void post_phase(const P& p, unsigned char* ws, int l, const int tid, const int bid) {
    u16* ofw = (u16*)(ws + OFF_OFW); const u16* obw = (const u16*)(ws + OFF_OBW); const u16* mix = (const u16*)(ws + OFF_MIX);
    const float* ng = p.ang + l * 1024;
    const int lane = tid & 63, wid = tid >> 6;
    const int nw = (int)gridDim.x * 8, NWI = M_ * 8 / 4;
    for (int wi0 = bid * 8 + wid; wi0 < NWI; wi0 += 4 * nw) {
        u32x4 a[4], bq[4], gt[4];
#pragma unroll
        for (int k = 0; k < 4; ++k) {
            const int wi = min(wi0 + k * nw, NWI - 1);
            const int idx = wi * 4 + (lane >> 4); const int tok = idx >> 3, hh = idx & 7, e0 = (lane & 15) * 8;
            a[k] = *(const u32x4*)(ofw + (size_t)tok * 1024 + hh * 128 + e0); bq[k] = *(const u32x4*)(obw + (size_t)tok * 1024 + hh * 128 + e0);
            gt[k] = *(const u32x4*)(mix + (size_t)tok * NMIX + 2048 + hh * 128 + e0);
        }
#pragma unroll
        for (int k = 0; k < 4; ++k) {
            const int wi = wi0 + k * nw;
            const int idx = wi * 4 + (lane >> 4); const int tok = idx >> 3, hh = idx & 7, e0 = (lane & 15) * 8;
            float o[8];
#pragma unroll
            for (int j = 0; j < 4; ++j) { o[2 * j] = bf_lo(a[k][j]) + bf_lo(bq[k][j]); o[2 * j + 1] = bf_hi(a[k][j]) + bf_hi(bq[k][j]); }
            float ss = 0.f;
#pragma unroll
            for (int j = 0; j < 8; ++j) ss += o[j] * o[j];
            ss += shx(ss, 1, lane); ss += shx(ss, 2, lane); ss += shx(ss, 4, lane); ss += shx(ss, 8, lane);
            const float rs = rsqrtf(ss * (1.0f / 128.0f) + 1e-6f);
            const f32x4 g0 = *(const f32x4*)(ng + hh * 128 + e0), g1 = *(const f32x4*)(ng + hh * 128 + e0 + 4);
            u32x4 w;
#pragma unroll
            for (int j = 0; j < 4; ++j) {
                const float gl = (j < 2) ? g0[2 * j] : g1[2 * j - 4], gh = (j < 2) ? g0[2 * j + 1] : g1[2 * j - 3];
                w[j] = cvt_pk_bf16(o[2 * j] * rs * gl * bf_lo(gt[k][j]), o[2 * j + 1] * rs * gh * bf_hi(gt[k][j]));
            }
            if (wi < NWI) *(u32x4*)(ofw + (size_t)tok * 1024 + hh * 128 + e0) = w;
        }
    }
}

constexpr int R_QG = 0, R_QM = 17408, R_KM = 34816, R_KDT = 52224, R_VT = 70656, R_ATT = 89088, R_DV = 98304, R_TOT = 98816;
__device__ __forceinline__ void rec1_phase(unsigned char* ws, LAS unsigned char* lds, const int tid, const int item) {
    const int wid = __builtin_amdgcn_readfirstlane(tid >> 6), lane = tid & 63;
    const int seq = item & 31, grp = item >> 5; const int dir = seq & 1, hh = (seq >> 1) & 7, b = seq >> 4;
    const u16* mix = (const u16*)(ws + OFF_MIX);
    u16* odir = (u16*)(ws + (dir ? OFF_OBW : OFF_OFW));
    const int sg = wid, c2 = 2 * lane;
    const int r = lane & 31, h = lane >> 5;
    const int kcp = (c2 & ~15) + 8 * ((c2 >> 2) & 1) + 4 * ((c2 >> 3) & 1) + (c2 & 3);
    LAS float* TOT = (LAS float*)(lds + R_TOT); LAS float* DV = (LAS float*)(lds + R_DV);
    f32x16 S[4];
#pragma unroll
    for (int kb = 0; kb < 4; ++kb)
#pragma unroll
        for (int e = 0; e < 16; ++e) S[kb][e] = 0.f;
    unsigned nlf[8], nq[8], nv[8];
    {
        const int co = dir ? 255 - grp * 32 : grp * 32; const size_t tok0 = (size_t)b * S_ + (size_t)co * 64;
#pragma unroll
        for (int i = 0; i < 8; ++i) { const int tau = 8 * sg + i, t = dir ? 63 - tau : tau; const u16* rp = mix + (tok0 + t) * NMIX + hh * 128 + c2;
            nlf[i] = *(const unsigned*)(rp + 3072 + dir * 1024); nq[i] = *(const unsigned*)(rp); nv[i] = *(const unsigned*)(rp + 1024); }
    }
    float gpre0 = 0.f, gpre1 = 0.f;
    float* GPRE = (float*)(ws + OFF_GPRE);
    for (int c = grp * 32; c < grp * 32 + 32; ++c) {
        const int co = dir ? 255 - c : c; const size_t tok0 = (size_t)b * S_ + (size_t)co * 64;
        float g0[8], g1[8]; float cs0 = 0.f, cs1 = 0.f;
#pragma unroll
        for (int i = 0; i < 8; ++i) { cs0 += h2f((u16)(nlf[i] & 0xffffu)); cs1 += h2f((u16)(nlf[i] >> 16)); g0[i] = cs0; g1[i] = cs1; }
        TOT[sg * 128 + c2] = cs0; TOT[sg * 128 + c2 + 1] = cs1;
        __syncthreads();
        float pre0 = 0.f, pre1 = 0.f, ref0 = 0.f, ref1 = 0.f, gl0 = 0.f, gl1 = 0.f;
#pragma unroll
        for (int s = 0; s < 8; ++s) {
            const float a0 = TOT[s * 128 + c2], a1 = TOT[s * 128 + c2 + 1];
            if (s < sg) { pre0 += a0; pre1 += a1; }
            if (s < 4) { ref0 += a0; ref1 += a1; }
            gl0 += a0; gl1 += a1;
        }
        float kd0[8], kd1[8];
#pragma unroll
        for (int i = 0; i < 8; ++i) {
            const float gi0 = pre0 + g0[i], gi1 = pre1 + g1[i];
            const float kk0 = 1.0f - fexp(h2f((u16)(nlf[i] & 0xffffu))), kk1 = 1.0f - fexp(h2f((u16)(nlf[i] >> 16)));
            const float q0 = bf_lo(nq[i]), q1 = bf_hi(nq[i]);
            kd0[i] = kk0 * fexp(gl0 - gi0); kd1[i] = kk1 * fexp(gl1 - gi1);
            const int tau = 8 * sg + i, t = dir ? 63 - tau : tau;
            *(LAS unsigned*)(lds + R_QG + t * 272 + kcp * 2) = cvt_pk_bf16(q0 * fexp(gi0), q1 * fexp(gi1));
            *(LAS unsigned*)(lds + R_QM + t * 272 + c2 * 2) = cvt_pk_bf16(q0 * fexp(fminf(gi0 - ref0, 80.f)), q1 * fexp(fminf(gi1 - ref1, 80.f)));
            *(LAS unsigned*)(lds + R_KM + t * 272 + c2 * 2) = cvt_pk_bf16(kk0 * fexp(fminf(ref0 - gi0, 80.f)), kk1 * fexp(fminf(ref1 - gi1, 80.f)));
        }
        {
            u32x4 w0, w1, x0, x1;
#pragma unroll
            for (int j = 0; j < 4; ++j) {
                w0[j] = dir ? cvt_pk_bf16(kd0[7 - 2 * j], kd0[6 - 2 * j]) : cvt_pk_bf16(kd0[2 * j], kd0[2 * j + 1]);
                w1[j] = dir ? cvt_pk_bf16(kd1[7 - 2 * j], kd1[6 - 2 * j]) : cvt_pk_bf16(kd1[2 * j], kd1[2 * j + 1]);
                const unsigned va = dir ? nv[7 - 2 * j] : nv[2 * j], vb = dir ? nv[6 - 2 * j] : nv[2 * j + 1];
                x0[j] = (va & 0xffffu) | (vb << 16);
                x1[j] = (va >> 16) | (vb & 0xffff0000u);
            }
            const int tb0 = dir ? 56 - 8 * sg : 8 * sg;
            *(LAS u32x4*)(lds + R_KDT + c2 * 144 + tb0 * 2) = w0; *(LAS u32x4*)(lds + R_KDT + (c2 + 1) * 144 + tb0 * 2) = w1;
            *(LAS u32x4*)(lds + R_VT + c2 * 144 + tb0 * 2) = x0; *(LAS u32x4*)(lds + R_VT + (c2 + 1) * 144 + tb0 * 2) = x1;
        }
        if (sg == 0) { DV[c2] = fexp(gl0); DV[c2 + 1] = fexp(gl1); GPRE[(size_t)(seq * 256 + c) * 128 + c2] = gpre0; GPRE[(size_t)(seq * 256 + c) * 128 + c2 + 1] = gpre1; }
        gpre0 += gl0; gpre1 += gl1;
        __syncthreads();
        if (c + 1 < grp * 32 + 32) {
            const int cn = dir ? 254 - c : c + 1; const size_t tokn = (size_t)b * S_ + (size_t)cn * 64;
#pragma unroll
            for (int i = 0; i < 8; ++i) { const int tau = 8 * sg + i, t = dir ? 63 - tau : tau; const u16* rp = mix + (tokn + t) * NMIX + hh * 128 + c2;
                nlf[i] = *(const unsigned*)(rp + 3072 + dir * 1024); nq[i] = *(const unsigned*)(rp); nv[i] = *(const unsigned*)(rp + 1024); }
        }
        if (wid < 4) {
            const int sb = wid & 1, tb = wid >> 1;
            f32x16 a;
#pragma unroll
            for (int e = 0; e < 16; ++e) a[e] = 0.f;
#pragma unroll
            for (int s8 = 0; s8 < 8; ++s8) {
                const bf16x8 A = *(const LAS bf16x8*)(lds + R_KM + (32 * sb + r) * 272 + (16 * s8 + 8 * h) * 2);
                const bf16x8 B = *(const LAS bf16x8*)(lds + R_QM + (32 * tb + r) * 272 + (16 * s8 + 8 * h) * 2);
                a = __builtin_amdgcn_mfma_f32_32x32x16_bf16(A, B, a, 0, 0, 0);
            }
            const int tau = 32 * tb + r;
#pragma unroll
            for (int gq = 0; gq < 4; ++gq) {
                const int sbase = 32 * sb + 8 * gq + 4 * h;
                float o[4];
#pragma unroll
                for (int e = 0; e < 4; ++e) { const int sig = sbase + e; const bool keep = dir ? (sig >= tau) : (sig <= tau); o[e] = keep ? a[4 * gq + e] : 0.f; }
                u32x2 w; w.x = cvt_pk_bf16(o[0], o[1]); w.y = cvt_pk_bf16(o[2], o[3]);
                *(LAS u32x2*)(lds + R_ATT + tau * 144 + sbase * 2) = w;
            }
        }
        __syncthreads();
        if (wid < 4) {
            const int vs = wid;
            bf16x8 Bv[4];
#pragma unroll
            for (int s = 0; s < 4; ++s) Bv[s] = *(const LAS bf16x8*)(lds + R_VT + (32 * vs + r) * 144 + (16 * s + 8 * h) * 2);
            bf16x8 Sb[4][2];
#pragma unroll
            for (int kb = 0; kb < 4; ++kb)
#pragma unroll
                for (int s = 0; s < 2; ++s) {
                    u32x4 w;
#pragma unroll
                    for (int j = 0; j < 4; ++j) w[j] = cvt_pk_bf16(S[kb][8 * s + 2 * j], S[kb][8 * s + 2 * j + 1]);
                    Sb[kb][s] = __builtin_bit_cast(bf16x8, w);
                }
#pragma unroll
            for (int tb = 0; tb < 2; ++tb) {
                f32x16 o;
#pragma unroll
                for (int e = 0; e < 16; ++e) o[e] = 0.f;
#pragma unroll
                for (int kb = 0; kb < 4; ++kb)
#pragma unroll
                    for (int s = 0; s < 2; ++s) {
                        const bf16x8 A = *(const LAS bf16x8*)(lds + R_QG + (32 * tb + r) * 272 + (32 * kb + 16 * s + 8 * h) * 2);
                        o = __builtin_amdgcn_mfma_f32_32x32x16_bf16(A, Sb[kb][s], o, 0, 0, 0);
                    }
#pragma unroll
                for (int s = 0; s < 4; ++s) {
                    const bf16x8 A = *(const LAS bf16x8*)(lds + R_ATT + (32 * tb + r) * 144 + (16 * s + 8 * h) * 2);
                    o = __builtin_amdgcn_mfma_f32_32x32x16_bf16(A, Bv[s], o, 0, 0, 0);
                }
#pragma unroll
                for (int e = 0; e < 16; ++e) {
                    const int t = 32 * tb + (e & 3) + 8 * (e >> 2) + 4 * h;
                    odir[(tok0 + t) * 1024 + hh * 128 + 32 * vs + r] = f2bf(o[e]);
                }
            }
#pragma unroll
            for (int kb = 0; kb < 4; ++kb) {
#pragma unroll
                for (int gq = 0; gq < 4; ++gq) {
                    const f32x4 d4 = *(const LAS f32x4*)(lds + R_DV + (32 * kb + 8 * gq + 4 * h) * 4);
#pragma unroll
                    for (int e = 0; e < 4; ++e) S[kb][4 * gq + e] *= d4[e];
                }
#pragma unroll
                for (int s = 0; s < 4; ++s) {
                    const bf16x8 A = *(const LAS bf16x8*)(lds + R_KDT + (32 * kb + r) * 144 + (16 * s + 8 * h) * 2);
                    S[kb] = __builtin_amdgcn_mfma_f32_32x32x16_bf16(A, Bv[s], S[kb], 0, 0, 0);
                }
            }
        }
        __syncthreads();
    }
    if (wid < 4) {
        float* sg_out = (float*)(ws + OFF_SGRP) + (size_t)(seq * 8 + grp) * 16384;
#pragma unroll
        for (int kb = 0; kb < 4; ++kb)
#pragma unroll
            for (int e = 0; e < 16; ++e) sg_out[(32 * kb + (e & 3) + 8 * (e >> 2) + 4 * h) * 128 + 32 * wid + r] = S[kb][e];
    }
    if (sg == 0) { float* gt = (float*)(ws + OFF_GTOT) + (size_t)(seq * 8 + grp) * 128; gt[c2] = gpre0; gt[c2 + 1] = gpre1; }
}

__device__ __forceinline__ void rec2_phase(unsigned char* ws, const int tid, const int bid) {
    const float* sgrp = (const float*)(ws + OFF_SGRP); const float* gtot = (const float*)(ws + OFF_GTOT); u16* sint = (u16*)(ws + OFF_SINT);
    for (int idx = bid * 512 + tid; idx < 32 * 16384; idx += (int)gridDim.x * 512) {
        const int seq = idx >> 14, k = (idx >> 7) & 127, v = idx & 127;
        float sgv[8], gtv[8];
#pragma unroll
        for (int g = 0; g < 8; ++g) { sgv[g] = sgrp[(size_t)(seq * 8 + g) * 16384 + k * 128 + v]; gtv[g] = gtot[(seq * 8 + g) * 128 + k]; }
        float sin = 0.f;
#pragma unroll
        for (int g = 0; g < 8; ++g) {
            sint[((size_t)(seq * 8 + g) * 128 + v) * 128 + k] = f2bf(sin);
            sin = fexp(gtv[g]) * sin + sgv[g];
        }
    }
}

constexpr int R3_QC = 0, R3_TOT = 17408;
__device__ __forceinline__ void rec3_phase(unsigned char* ws, LAS unsigned char* lds, const int tid, const int bid) {
    const int wid = __builtin_amdgcn_readfirstlane(tid >> 6), lane = tid & 63;
    const u16* mix = (const u16*)(ws + OFF_MIX);
    const float* GPRE = (const float*)(ws + OFF_GPRE);
    const int sg = wid, c2 = 2 * lane, r = lane & 31, h = lane >> 5;
    LAS float* TOT = (LAS float*)(lds + R3_TOT);
    for (int u = bid; u < 32 * 224; u += (int)gridDim.x) {
        const int seq = u & 31, c = 32 + (u >> 5), grp = c >> 5;
        const int dir = seq & 1, hh = (seq >> 1) & 7, b = seq >> 4;
        const int co = dir ? 255 - c : c; const size_t tok0 = (size_t)b * S_ + (size_t)co * 64;
        u16* odir = (u16*)(ws + (dir ? OFF_OBW : OFF_OFW));
        const float gp0 = GPRE[(size_t)(seq * 256 + c) * 128 + c2], gp1 = GPRE[(size_t)(seq * 256 + c) * 128 + c2 + 1];
        if (__all((gp0 < -87.5f) && (gp1 < -87.5f))) continue;
        unsigned nlf[8], nq[8];
#pragma unroll
        for (int i = 0; i < 8; ++i) { const int tau = 8 * sg + i, t = dir ? 63 - tau : tau; const u16* rp = mix + (tok0 + t) * NMIX + hh * 128 + c2;
            nlf[i] = *(const unsigned*)(rp + 3072 + dir * 1024); nq[i] = *(const unsigned*)(rp); }
        float g0[8], g1[8]; float cs0 = 0.f, cs1 = 0.f;
#pragma unroll
        for (int i = 0; i < 8; ++i) { cs0 += h2f((u16)(nlf[i] & 0xffffu)); cs1 += h2f((u16)(nlf[i] >> 16)); g0[i] = cs0; g1[i] = cs1; }
        TOT[sg * 128 + c2] = cs0; TOT[sg * 128 + c2 + 1] = cs1;
        __syncthreads();
        float pre0 = gp0, pre1 = gp1;
#pragma unroll
        for (int s = 0; s < 8; ++s) { if (s < sg) { pre0 += TOT[s * 128 + c2]; pre1 += TOT[s * 128 + c2 + 1]; } }
#pragma unroll
        for (int i = 0; i < 8; ++i) {
            const int tau = 8 * sg + i, t = dir ? 63 - tau : tau;
            *(LAS unsigned*)(lds + R3_QC + t * 272 + c2 * 2) = cvt_pk_bf16(bf_lo(nq[i]) * fexp(pre0 + g0[i]), bf_hi(nq[i]) * fexp(pre1 + g1[i]));
        }
        __syncthreads();
        {
            const int tb = wid & 1, vq = wid >> 1;
            const u16* sin = (const u16*)(ws + OFF_SINT) + ((size_t)(seq * 8 + grp) * 128 + 32 * vq + r) * 128 + 8 * h;
            f32x16 o;
#pragma unroll
            for (int e = 0; e < 16; ++e) o[e] = 0.f;
#pragma unroll
            for (int s = 0; s < 8; ++s) {
                const bf16x8 A = *(const LAS bf16x8*)(lds + R3_QC + (32 * tb + r) * 272 + (16 * s + 8 * h) * 2);
                const bf16x8 B = *(const bf16x8*)(sin + 16 * s);
                o = __builtin_amdgcn_mfma_f32_32x32x16_bf16(A, B, o, 0, 0, 0);
            }
            u16* op0 = odir + (tok0 + 32 * tb + 4 * h) * 1024 + hh * 128 + 32 * vq + r;
            u16 old[16];
#pragma unroll
            for (int e = 0; e < 16; ++e) old[e] = op0[((e & 3) + 8 * (e >> 2)) * 1024];
#pragma unroll
            for (int e = 0; e < 16; ++e) op0[((e & 3) + 8 * (e >> 2)) * 1024] = f2bf(bf2f(old[e]) + o[e]);
        }
        __syncthreads();
    }
}

__device__ __forceinline__ void na_phase(const P& p, unsigned char* ws, int l, LAS unsigned char* lds, int blk0, const int tid, const int bid) {
    const int wid = tid >> 6, lane = tid & 63, q15 = lane & 15, g = lane >> 4;
    LAS float* rp = (LAS float*)(lds + 256);
    for (int i = tid; i < 3720; i += 512) rp[i] = p.rpb[l * 3720 + i];
    __syncthreads();
    const u16* mix = (const u16*)(ws + OFF_MIX); const u16* vT = (const u16*)(ws + OFF_VT); u16* ob = (u16*)(ws + OFF_OB);
    const int nw = ((int)gridDim.x - blk0) * 8;
    const int lb = (((bid - blk0) & 7) * (((int)gridDim.x - blk0) >> 3)) + ((bid - blk0) >> 3);
    for (int item = ((((int)gridDim.x - blk0) & 7) == 0 ? lb : (bid - blk0)) * 8 + wid; item < 16384; item += nw) {
        const int j = item & 3, hh = (item >> 2) & 7, r = (item >> 5) & 255, b = item >> 13;
        const int base = b * S_;
        const int rs = min(max(r - 4, 0), 248), c0 = min(max(16 * j - 8, 0), 32);
        const int tq = base + r * 64 + 16 * j + q15;
        bf16x8 Qf[4];
#pragma unroll
        for (int ks = 0; ks < 4; ++ks) Qf[ks] = *(const bf16x8*)(mix + (size_t)tq * NMIX + 5120 + hh * 128 + 32 * ks + 8 * g);
        const u16* kbase = mix + ((size_t)(base + rs * 64 + c0 + 8 * (q15 >> 2) + (q15 & 3))) * NMIX + 6144 + hh * 128 + 8 * g;
        const u16* vbase = vT + ((size_t)((b * 8 + hh) * 128 + q15)) * 16384 + rs * 64 + c0 + 8 * g;
        bf16x8 KB[2][16];
#define NA_LOADK(bt) do { _Pragma("unroll") for (int tt = 0; tt < 4; ++tt) _Pragma("unroll") for (int ks = 0; ks < 4; ++ks) { const int t_ = 4 * (bt) + tt; \
            KB[(bt) & 1][tt * 4 + ks] = *(const bf16x8*)(kbase + (size_t)((t_ >> 1) * 64 + 4 * (t_ & 1)) * NMIX + 32 * ks); } } while (0)
#define NA_LOADV(vb) do { _Pragma("unroll") for (int dd = 0; dd < 2; ++dd) _Pragma("unroll") for (int kk = 0; kk < 8; ++kk) \
            VB[(vb) & 1][dd * 8 + kk] = *(const bf16x8*)(vbase + (size_t)(16 * (2 * (vb) + dd)) * 16384 + kk * 64); } while (0)
        f32x4 st[16];
        NA_LOADK(0); NA_LOADK(1);
        const int cq = 16 * j + q15, cs = min(max(cq - 8, 0), 48);
        const LAS float* rb0 = rp + hh * 465 + (rs - r + 7) * 31 + (c0 + 8 * g - cq + 15);
        __builtin_amdgcn_sched_barrier(0);
#pragma unroll
        for (int bt = 0; bt < 4; ++bt) {
#pragma unroll
            for (int tt = 0; tt < 4; ++tt) {
                const LAS float* rb = rb0 + ((4 * bt + tt) >> 1) * 31 + 4 * (tt & 1);
                f32x4 a = (f32x4){rb[0], rb[1], rb[2], rb[3]};
#pragma unroll
                for (int ks = 0; ks < 4; ++ks) a = __builtin_amdgcn_mfma_f32_16x16x32_bf16(KB[bt & 1][tt * 4 + ks], Qf[ks], a, 0, 0, 0);
                st[4 * bt + tt] = a;
            }
            if (bt == 0) NA_LOADK(2);
            if (bt == 1) NA_LOADK(3);
            __builtin_amdgcn_sched_barrier(0);
        }
        bf16x8 VB[2][16];
        NA_LOADV(0); NA_LOADV(1);
        __builtin_amdgcn_sched_barrier(0);
        float mx = -1e30f;
#pragma unroll
        for (int t = 0; t < 16; ++t) {
            const int hf = t & 1;
#pragma unroll
            for (int e = 0; e < 4; ++e) {
                const int kcol = c0 + 8 * g + 4 * hf + e;
                const bool valid = (kcol >= cs) && (kcol < cs + 16);
                const float sc = valid ? st[t][e] : -1e30f;
                st[t][e] = sc; mx = fmaxf(mx, sc);
            }
        }
        mx = fmaxf(mx, shx(mx, 16, lane)); mx = fmaxf(mx, shx(mx, 32, lane));
        float sum = 0.f;
#pragma unroll
        for (int t = 0; t < 16; ++t)
#pragma unroll
            for (int e = 0; e < 4; ++e) { const float pv = fexp(st[t][e] - mx); st[t][e] = pv; sum += pv; }
        sum += shx(sum, 16, lane); sum += shx(sum, 32, lane);
        const float inv = 1.0f / sum;
        bf16x8 Pf[8];
#pragma unroll
        for (int kk = 0; kk < 8; ++kk) {
            u32x4 w; w.x = cvt_pk_bf16(st[2 * kk][0], st[2 * kk][1]); w.y = cvt_pk_bf16(st[2 * kk][2], st[2 * kk][3]);
            w.z = cvt_pk_bf16(st[2 * kk + 1][0], st[2 * kk + 1][1]); w.w = cvt_pk_bf16(st[2 * kk + 1][2], st[2 * kk + 1][3]);
            Pf[kk] = __builtin_bit_cast(bf16x8, w);
        }
        __builtin_amdgcn_sched_barrier(0);
#pragma unroll
        for (int vb = 0; vb < 4; ++vb) {
#pragma unroll
            for (int dd = 0; dd < 2; ++dd) {
                f32x4 O = (f32x4){0.f, 0.f, 0.f, 0.f};
#pragma unroll
                for (int kk = 0; kk < 8; ++kk) O = __builtin_amdgcn_mfma_f32_16x16x32_bf16(VB[vb & 1][dd * 8 + kk], Pf[kk], O, 0, 0, 0);
                u32x2 w; w.x = cvt_pk_bf16(O[0] * inv, O[1] * inv); w.y = cvt_pk_bf16(O[2] * inv, O[3] * inv);
                *(u32x2*)(ob + (size_t)tq * 1024 + hh * 128 + 16 * (2 * vb + dd) + 4 * g) = w;
            }
            if (vb == 0) NA_LOADV(2);
            if (vb == 1) NA_LOADV(3);
            __builtin_amdgcn_sched_barrier(0);
        }
#undef NA_LOADK
#undef NA_LOADV
    }
}

#define XB_TMO      128
#define XB_XCNT(j)  (256  + 64 * (j))
#define XB_XSUB(j)  (1280 + 64 * (j))
#define XB_XGEN(j)  (2304 + 64 * (j))
#define XB_TOP      3328
#define XB_TOPGEN   3392
#define XCD_BAR_WORDS 3456
#define XB_SPIN_CAP (1u << 22)
__device__ __forceinline__ unsigned xb_ld(unsigned* p)              { return __hip_atomic_load(p, __ATOMIC_RELAXED, __HIP_MEMORY_SCOPE_AGENT); }
__device__ __forceinline__ unsigned xb_add(unsigned* p, unsigned v) { return __hip_atomic_fetch_add(p, v, __ATOMIC_RELAXED, __HIP_MEMORY_SCOPE_AGENT); }
__device__ __forceinline__ unsigned xb_xcc_id() { return (unsigned)__builtin_amdgcn_s_getreg((3 << 11) | 20) & 0xFu; }
#define XB_SPIN(cond, bar) do { unsigned _sp = 0; while (cond) { __builtin_amdgcn_s_sleep(1); \
    if ((++_sp & 255u) == 0u) { if (xb_ld(&(bar)[XB_TMO])) break; if (_sp > XB_SPIN_CAP) { atomicAdd(&(bar)[XB_TMO], 1u); break; } } } } while (0)
struct XcdBarrier { unsigned* bar; unsigned x; volatile LAS unsigned* st; };
__device__ __forceinline__ XcdBarrier xcd_barrier_post(unsigned* bar, volatile LAS unsigned* st) {
    XcdBarrier b; b.bar = bar; b.x = xb_xcc_id(); b.st = st;
    if (threadIdx.x == 0) (void)xb_add(&bar[XB_XCNT(b.x)], 1u);
    return b;
}
__device__ __forceinline__ void xcd_barrier_complete(unsigned* bar, unsigned x, unsigned& nloc, unsigned& nx) {
    const unsigned G = gridDim.x * gridDim.y * gridDim.z;
    unsigned sum, cnt, mine, sp = 0u;
    for (;;) {
        sum = 0u; cnt = 0u; mine = 0u;
#pragma unroll
        for (unsigned j = 0; j < 16; ++j) { const unsigned c = xb_ld(&bar[XB_XCNT(j)]); sum += c; cnt += (c > 0u) ? 1u : 0u; mine = (j == x) ? c : mine; }
        if (sum == G) break;
        __builtin_amdgcn_s_sleep(1);
        if ((++sp & 255u) == 0u) { if (xb_ld(&bar[XB_TMO])) break; if (sp > XB_SPIN_CAP) { atomicAdd(&bar[XB_TMO], 1u); break; } }
    }
    nloc = mine > 0u ? mine : 1u; nx = cnt > 0u ? cnt : 1u;
}
__device__ __forceinline__ void xcd_barrier(const XcdBarrier& b) {
    asm volatile("s_waitcnt vmcnt(0)" ::: "memory");
    __syncthreads();
    if (threadIdx.x == 0) {
        unsigned* bar = b.bar;
        __builtin_amdgcn_s_waitcnt(0);
        unsigned nloc = b.st[0], nx = b.st[1];
        if (nloc == 0u) { xcd_barrier_complete(bar, b.x, nloc, nx); b.st[0] = nloc; b.st[1] = nx; }
        const unsigned old = xb_add(&bar[XB_XSUB(b.x)], 1u);
        const unsigned gen = old / nloc;
        if (old + 1u == (gen + 1u) * nloc) {
            __builtin_amdgcn_fence(__ATOMIC_RELEASE, "agent");
            asm volatile("s_waitcnt vmcnt(0)" ::: "memory");
            const unsigned og = xb_add(&bar[XB_TOP], 1u);
            const unsigned tg = og / nx;
            if (og + 1u == (tg + 1u) * nx) xb_add(&bar[XB_TOPGEN], 1u);
            else XB_SPIN(xb_ld(&bar[XB_TOPGEN]) == tg, bar);
            __builtin_amdgcn_fence(__ATOMIC_ACQUIRE, "agent");
            xb_add(&bar[XB_XGEN(b.x)], 1u);
            asm volatile("s_waitcnt vmcnt(0)" ::: "memory");
        } else {
            XB_SPIN(xb_ld(&bar[XB_XGEN(b.x)]) == gen, bar);
            __builtin_amdgcn_fence(__ATOMIC_ACQUIRE, "agent");
            asm volatile("s_waitcnt vmcnt(0)" ::: "memory");
        }
    }
    __syncthreads();
}

constexpr int NPH = 25, LDS_BYTES = 131072 + 16, NREC = 32;
#ifndef PHMASK
#define PHMASK 0xFFFF
#endif
#ifndef REPMASK
#define REPMASK 0
#endif
__global__ void __launch_bounds__(512, 2) mk_fwd(P p) {
    extern __shared__ __attribute__((aligned(16))) unsigned char shm[];
    LAS unsigned char* lds = (LAS unsigned char*)shm;
    volatile LAS unsigned* xbst = (volatile LAS unsigned*)(lds + 131072);
    if (threadIdx.x == 0) { xbst[0] = 0u; xbst[1] = 0u; xbst[2] = 0u; xbst[3] = 0u; }
    if (p.coop) {
        if (blockIdx.x == 0) { unsigned* bw = (unsigned*)(p.ws + OFF_BAR); for (int i = threadIdx.x; i < XCD_BAR_WORDS; i += 512) bw[i] = 0u; }
        asm volatile("s_waitcnt vmcnt(0) lgkmcnt(0)" ::: "memory");
        cg::this_grid().sync();
    }
    __syncthreads();
    const XcdBarrier xb = xcd_barrier_post((unsigned*)(p.ws + OFF_BAR), xbst);
    int rep = 0;
    for (int ph = p.ph_lo; ph < p.ph_hi;) {
        int tid = threadIdx.x, bid = blockIdx.x; unsigned long long zo = 0;
        asm volatile("" : "+v"(tid)); asm volatile("" : "+s"(bid)); asm volatile("" : "+s"(zo));
        unsigned char* ws = p.ws + zo;
        if (ph == 0) {
            {
                conv_A(p, ws, 0, lds, tid, bid);
                cvt_flat(p.x, (u16*)(ws + OFF_XB), (size_t)M_ * D_ / 4, tid, bid);
            }
        } else {
            const int l = (ph - 1) / 12, sp = (ph - 1) % 12;
            if (sp == 0 && (PHMASK & 1)) {
                Sched1 S{(const char*)(ws + OFF_XB), (const char*)(ws + OFF_WIN), 2048, 128, 32, 0, bid};
                EpiG1a E{(u16*)(ws + OFF_MIX), (u16*)(ws + OFF_VT), p.b_in + l * 12288, p.lbl, l};
                gemm_phase(lds, S, E, tid);
            } else if (sp == 1 && (PHMASK & 2)) {
                for (int item = bid; item < 256; item += (int)gridDim.x) rec1_phase(ws, lds, tid, item);
            } else if (sp == 2 && (PHMASK & 4)) {
                rec2_phase(ws, tid, bid);
                na_phase(p, ws, l, lds, 0, tid, bid);
            } else if (sp == 3 && (PHMASK & 8)) {
                rec3_phase(ws, lds, tid, bid);
            } else if (sp == 4 && (PHMASK & 16)) {
                post_phase(p, ws, l, tid, bid);
            } else if (sp == 5 && (PHMASK & 32)) {
                Sched1 S{(const char*)(ws + OFF_XB), (const char*)(ws + OFF_WIN), 2048, 128, 16, 32, bid};
                EpiG1b E{(u16*)(ws + OFF_GATES), p.b_in + l * 12288};
                gemm_phase(lds, S, E, tid);
            } else if (sp == 6 && (PHMASK & 64)) {
                Sched2 S{(const char*)(ws + OFF_OFW), (const char*)(ws + OFF_WBR), (const char*)(ws + OFF_OB), (const char*)(ws + OFF_WBR + 2048 * 1024 * 2), 1024, 1024, 128, 8, bid};
                EpiG3 E{(const u16*)(ws + OFF_GATES), (u16*)(ws + OFF_MERGED)};
                gemm_phase(lds, S, E, tid);
            } else if (sp == 7 && (PHMASK & 128)) {
                Sched1 S{(const char*)(ws + OFF_MERGED), (const char*)(ws + OFF_WOUT), 2048, 128, 8, 0, bid};
                if (l == 0) { EpiG4<0> E{p.x, p.out, (const float*)(ws + OFF_STATS), p.ln2g, p.ln2b}; gemm_phase(lds, S, E, tid); }
                else { EpiG4<1> E{p.out, p.out, (const float*)(ws + OFF_STATS), p.ln2g, p.ln2b}; gemm_phase(lds, S, E, tid); }
            } else if (sp == 8 && (PHMASK & 256)) {
                ln_phase<0>(p.out, p.ln1g + l * 2048, p.ln1b + l * 2048, (u16*)(ws + OFF_XB), (float*)(ws + OFF_STATS), tid, bid);
                __syncthreads();
                conv_B(p, ws, l, lds, tid, bid);
            } else if (sp == 9 && (PHMASK & 512)) {
                Sched1 S{(const char*)(ws + OFF_XB), (const char*)(ws + OFF_WUPG), 2048, 128, 52, 0, bid};
                EpiG6 E{(u16*)(ws + OFF_H), (u16*)(ws + OFF_SG)};
                gemm_phase(lds, S, E, tid);
            } else if (sp == 10 && (PHMASK & 1024)) {
                Sched2 S{(const char*)(ws + OFF_PB), (const char*)(ws + OFF_WPE), (const char*)(ws + OFF_H), (const char*)(ws + OFF_WDOWN), 256, FH, 128, 8, bid};
                EpiG7 E{(const u16*)(ws + OFF_SG), p.out, (const float*)(ws + OFF_STATS), p.ln1g + l * 2048, p.ln1b + l * 2048};
                gemm_phase(lds, S, E, tid);
            } else if (sp == 11 && (PHMASK & 2048)) {
                if (l == 0) ln_phase<0>(p.out, p.ln2g, p.ln2b, (u16*)(ws + OFF_XB), (float*)(ws + OFF_STATS), tid, bid);
                else ln_phase<1>(p.out, p.ln2g + 2048, p.ln2b + 2048, (u16*)(ws + OFF_XB), (float*)(ws + OFF_STATS), tid, bid);
                if (l == 0) { __syncthreads(); conv_A(p, ws, 1, lds, tid, bid); }
            }
        }
        if (REPMASK != 0 && ph > 0 && ((REPMASK >> ((ph - 1) % 12)) & 1) && rep == 0) rep = 1; else { rep = 0; ++ph; }
        if (ph < p.ph_hi) {
            if (p.coop) {
                xcd_barrier(xb);
            }
        }
        __syncthreads();
    }
}

extern "C" void kernel_launch(void* const* d_in, const int* in_sizes, int n_in, void* d_out, int out_size, void* d_ws, size_t ws_size, hipStream_t stream) {
    static int grid = 0;
    if (grid == 0) {
        if (ws_size < WS_END) { fprintf(stderr, "kernel_launch: workspace too small: %zu < %zu\n", ws_size, (size_t)WS_END); grid = -1; return; }
        if (hipFuncSetAttribute((const void*)mk_fwd, hipFuncAttributeMaxDynamicSharedMemorySize, LDS_BYTES) != hipSuccess) { fprintf(stderr, "kernel_launch: hipFuncSetAttribute failed\n"); grid = -1; return; }
        int dev = 0, cus = 0, per_cu = 0;
        hipGetDevice(&dev);
        hipDeviceGetAttribute(&cus, hipDeviceAttributeMultiprocessorCount, dev);
        if (hipOccupancyMaxActiveBlocksPerMultiprocessor(&per_cu, (const void*)mk_fwd, 512, LDS_BYTES) != hipSuccess || per_cu < 1) { fprintf(stderr, "kernel_launch: occupancy query failed (%d)\n", per_cu); (void)hipGetLastError(); per_cu = 1; }
        grid = cus * 1;
        if (grid < 64) { fprintf(stderr, "kernel_launch: unexpected CU count %d\n", cus); grid = -1; return; }
    }
    if (grid < 0) return;
    P p{};
    p.x = (const float*)d_in[0]; p.p = (const float*)d_in[1]; p.w_in = (const float*)d_in[2]; p.b_in = (const float*)d_in[3]; p.lbl = (const float*)d_in[4];
    p.ang = (const float*)d_in[5]; p.rpb = (const float*)d_in[6]; p.w_branch = (const float*)d_in[7]; p.w_out = (const float*)d_in[8];
    p.ln1g = (const float*)d_in[9]; p.ln1b = (const float*)d_in[10]; p.w_up = (const float*)d_in[11]; p.w_down = (const float*)d_in[12];
    p.w_pe = (const float*)d_in[13]; p.w_pg = (const float*)d_in[14]; p.ln2g = (const float*)d_in[15]; p.ln2b = (const float*)d_in[16];
    p.out = (float*)d_out; p.ws = (unsigned char*)d_ws; p.coop = 0; p.pad = 0;
    p.ph_lo = 0; p.ph_hi = NPH; p.coop = 1;
    void* args[] = {&p};
    hipError_t e = hipLaunchCooperativeKernel((const void*)mk_fwd, dim3(grid), dim3(512), args, LDS_BYTES, stream);
    if (e != hipSuccess) fprintf(stderr, "kernel_launch: cooperative launch failed: %s (grid %d)\n", hipGetErrorString(e), grid);
}
```

```cpp
#include <hip/hip_runtime.h>
#include <hip/hip_cooperative_groups.h>
#include <cstdio>
namespace cg = cooperative_groups;

#define LAS __attribute__((address_space(3)))
typedef unsigned short u16;
typedef short bf16x8 __attribute__((ext_vector_type(8)));
typedef short s16x4 __attribute__((ext_vector_type(4)));
typedef float f32x4 __attribute__((ext_vector_type(4)));
typedef float f32x16 __attribute__((ext_vector_type(16)));
typedef unsigned u32x4 __attribute__((ext_vector_type(4)));
typedef unsigned u32x2 __attribute__((ext_vector_type(2)));

constexpr int M_ = 32768, D_ = 2048, S_ = 16384, NMIX = 8192, FH = 5632;
constexpr float ALPHA = 1.41421356237f;

constexpr size_t OFF_XB = 0;
constexpr size_t OFF_WIN = 134217728;
constexpr size_t OFF_WBR = OFF_WIN + 50331648;
constexpr size_t OFF_WOUT = OFF_WBR + 8388608;
constexpr size_t OFF_MIX = 201326592;
constexpr size_t OFF_VT = 738197504;
constexpr size_t OFF_OFW = 805306368;
constexpr size_t OFF_OBW = 872415232;
constexpr size_t OFF_OB = 939524096;
constexpr size_t OFF_SGRP = 1006632960;
constexpr size_t OFF_SINT = OFF_SGRP + 16777216;
constexpr size_t OFF_GPRE = OFF_SINT + 8388608;
constexpr size_t OFF_GTOT = OFF_GPRE + 4194304;
constexpr size_t OFF_BAR = OFF_GTOT + 131072;
constexpr size_t OFF_STATS = OFF_BAR + 16384;
constexpr size_t WS_END = OFF_STATS + 262144;
constexpr size_t OFF_GATES = OFF_MIX;
constexpr size_t OFF_MERGED = OFF_MIX + 268435456;
constexpr size_t OFF_H = OFF_MIX;
constexpr size_t OFF_SG = OFF_MIX + 369098752;
constexpr size_t OFF_WUPG = OFF_OFW;
constexpr size_t OFF_WDOWN = OFF_WUPG + 54525952;
constexpr size_t OFF_WPE = OFF_WDOWN + 23068672;
constexpr size_t OFF_PB = OFF_WPE + 1048576;

struct P {
    const float *x, *p, *w_in, *b_in, *lbl, *ang, *rpb, *w_branch, *w_out, *ln1g, *ln1b, *w_up, *w_down, *w_pe, *w_pg, *ln2g, *ln2b;
    float* out; unsigned char* ws; int ph_lo, ph_hi, coop, pad;
};

typedef __bf16 bf16v2 __attribute__((ext_vector_type(2)));
typedef float f32x2 __attribute__((ext_vector_type(2)));
__device__ __forceinline__ unsigned cvt_pk_bf16(float lo, float hi) { f32x2 f = {lo, hi}; bf16v2 b = __builtin_convertvector(f, bf16v2); return __builtin_bit_cast(unsigned, b); }
__device__ __forceinline__ float shx(float v, int o, int lane) { return __int_as_float(__builtin_amdgcn_ds_bpermute((lane ^ o) << 2, __float_as_int(v))); }
__device__ __forceinline__ float bf_lo(unsigned w) { return __uint_as_float(w << 16); }
__device__ __forceinline__ float bf_hi(unsigned w) { return __uint_as_float(w & 0xffff0000u); }
__device__ __forceinline__ float bf2f(u16 b) { return __uint_as_float(((unsigned)b) << 16); }
__device__ __forceinline__ u16 f2bf(float f) { return (u16)(cvt_pk_bf16(f, 0.f) & 0xffffu); }
__device__ __forceinline__ float fexp(float v) { return __builtin_amdgcn_exp2f(v * 1.44269504089f); }
__device__ __forceinline__ float sigm(float v) { return __builtin_amdgcn_rcpf(1.0f + fexp(-v)); }
__device__ __forceinline__ float silu(float v) { return v * sigm(v); }
__device__ __forceinline__ u16 f2h(float f) { _Float16 h = (_Float16)f; return __builtin_bit_cast(u16, h); }
__device__ __forceinline__ float h2f(u16 b) { return (float)__builtin_bit_cast(_Float16, b); }

constexpr int BM = 256, BK = 64, HALF = 128, HTB = HALF * BK * 2, NXCD = 8, WGM = 8;
__device__ __forceinline__ int lds_byte(int r, int c) { const int st = (r >> 4) * 2 + (c >> 5), rr = r & 15, cc = c & 31, ob = rr * 64 + cc * 2; return st * 1024 + (ob ^ (((ob >> 9) & 1) << 5)); }
__device__ __forceinline__ void stage_rc(int b, int& R, int& C) { const int st = b / 1024, sb = b % 1024, swz = sb ^ (((sb >> 9) & 1) << 5); R = (st >> 1) * 16 + swz / 64; C = (st & 1) * 32 + (swz % 64) / 2; }

struct Unit { const char* A; const char* B; int K; int pm, pn, seg, fin; };

__device__ __forceinline__ void tile_of(int L, int nM, int nN, int& pm, int& pn) {
    const int nwg = nM * nN; int wgid = L;
    { const int q = nwg / NXCD, r = nwg % NXCD, xcd = wgid % NXCD, off = wgid / NXCD; wgid = (xcd < r ? xcd * (q + 1) : r * (q + 1) + (xcd - r) * q) + off; }
    const int nig = WGM * nN, gid = wgid / nig, fm = gid * WGM, gsz = (nM - fm) < WGM ? (nM - fm) : WGM;
    pm = fm + ((wgid % nig) % gsz); pn = (wgid % nig) / gsz;
}
struct Sched1 {
    const char* A; const char* B; int K, nM, nN, pn0, bid;
    __device__ __forceinline__ bool next(int i, Unit& u) const {
        const int L = i * (int)gridDim.x + bid; if (L >= nM * nN) return false;
        tile_of(L, nM, nN, u.pm, u.pn);
        u.A = A + (size_t)u.pm * 256 * K * 2; u.B = B + (size_t)(u.pn + pn0) * 256 * K * 2; u.K = K; u.seg = 0; u.fin = 1; return true;
    }
};
struct Sched2 {
    const char *A0, *B0, *A1, *B1; int K0, K1, nM, nN, bid;
    __device__ __forceinline__ bool next(int i, Unit& u) const {
        const int L = (i >> 1) * (int)gridDim.x + bid; if (L >= nM * nN) return false;
        tile_of(L, nM, nN, u.pm, u.pn); const int sg = i & 1; const int K = sg ? K1 : K0;
        u.A = (sg ? A1 : A0) + (size_t)u.pm * 256 * K * 2; u.B = (sg ? B1 : B0) + (size_t)u.pn * 256 * K * 2; u.K = K; u.seg = sg; u.fin = sg; return true;
    }
};

template <class Sched, class Epi>
__device__ __forceinline__ void gemm_phase(LAS unsigned char* lds, const Sched& S, const Epi& E, const int tid) {
    const int wid = __builtin_amdgcn_readfirstlane(tid >> 6), lane = tid & 63, wr = wid >> 2, wc = wid & 3, fr = lane & 15, fq = lane >> 4;
    int RR0, C20;
    { int R, C; stage_rc(tid * 16, R, C); RR0 = R; C20 = C * 2; }
    const size_t kstep = (size_t)(BK * 2);
    const unsigned ldsw = (unsigned)wid * 1024u;
    const int aoff = lds_byte(wr * 64 + fr, fq * 8), boff = lds_byte(wc * 32 + fr, fq * 8);
#define G_SA(b, h) (((b) * 2 + (h)) * HTB)
#define G_SB(b, h) ((4 + (b) * 2 + (h)) * HTB)
#define G_STAGE(bufoff, gbase, ld2) do { _Pragma("unroll") for (int _i = 0; _i < 2; ++_i) \
        __builtin_amdgcn_global_load_lds((const unsigned*)((const char*)(gbase) + (unsigned)((RR0 + 64 * _i) * (ld2) + C20)), (LAS unsigned*)(lds + (bufoff) + ldsw + _i * 8192), 16, 0, 0); } while (0)
#define G_LDA(dst, b, h) do { _Pragma("unroll") for (int m = 0; m < 4; ++m) _Pragma("unroll") for (int k = 0; k < 2; ++k) dst[m][k] = *(const LAS bf16x8*)(lds + G_SA(b, h) + aoff + m * 2048 + k * 1024); } while (0)
#define G_LDB(dst, b, h) do { _Pragma("unroll") for (int n = 0; n < 2; ++n) _Pragma("unroll") for (int k = 0; k < 2; ++k) dst[n][k] = *(const LAS bf16x8*)(lds + G_SB(b, h) + boff + n * 2048 + k * 1024); } while (0)
#define G_MMA(ai, bj, At, Bt) do { __builtin_amdgcn_s_setprio(1); _Pragma("unroll") for (int m = 0; m < 4; ++m) _Pragma("unroll") for (int n = 0; n < 2; ++n) _Pragma("unroll") for (int k = 0; k < 2; ++k) \
        acc[ai][bj][m][n] = __builtin_amdgcn_mfma_f32_16x16x32_bf16(Bt[n][k], At[m][k], acc[ai][bj][m][n], 0, 0, 0); __builtin_amdgcn_s_setprio(0); } while (0)
#define G_WAIT_V(n) asm volatile("s_waitcnt vmcnt(" #n ")" ::: "memory")
#define G_WAIT_L(n) asm volatile("s_waitcnt lgkmcnt(" #n ")" ::: "memory")
#define G_BAR __builtin_amdgcn_s_barrier()
#define G_SCHED __builtin_amdgcn_sched_barrier(0)
    Unit cur, nxt; int ui = 0;
    if (!S.next(0, cur)) return;
    f32x4 acc[2][2][4][2];
#pragma unroll
    for (int a = 0; a < 2; ++a)
#pragma unroll
        for (int b = 0; b < 2; ++b)
#pragma unroll
            for (int m = 0; m < 4; ++m)
#pragma unroll
                for (int n = 0; n < 2; ++n) acc[a][b][m][n] = (f32x4){0.f, 0.f, 0.f, 0.f};
    bf16x8 At[4][2], B0[2][2], B1[2][2];
    const char* cA = cur.A; const char* cB = cur.B;
    {
        const int ld2 = cur.K * 2; const size_t hstep = (size_t)HALF * ld2;
        G_STAGE(G_SB(0, 0), cB, ld2); G_STAGE(G_SA(0, 0), cA, ld2); G_STAGE(G_SB(0, 1), cB + hstep, ld2); G_STAGE(G_SA(0, 1), cA + hstep, ld2);
        if (wr == 1) G_BAR;
        G_WAIT_V(4); G_BAR;
        G_STAGE(G_SB(1, 0), cB + kstep, ld2); G_STAGE(G_SA(1, 0), cA + kstep, ld2); G_STAGE(G_SB(1, 1), cB + hstep + kstep, ld2);
        G_WAIT_V(6); G_BAR;
    }
    for (;;) {
        const bool has_next = S.next(ui + 1, nxt);
        const char* nA = has_next ? nxt.A : cA; const char* nB = has_next ? nxt.B : cB;
        const int ld2c = cur.K * 2, ld2n = has_next ? nxt.K * 2 : ld2c;
        const size_t hstepc = (size_t)HALF * ld2c;
        const int nt = cur.K / BK;
        for (int t = 0; t < nt; t += 2) {
            const bool last = (t == nt - 2);
            const char* a1 = cA + (size_t)(t + 1) * kstep;
            const char* a2 = last ? nA : cA + (size_t)(t + 2) * kstep; const char* b2 = last ? nB : cB + (size_t)(t + 2) * kstep;
            const int ld2x = last ? ld2n : ld2c; const size_t hstepx = (size_t)HALF * ld2x;
            const char* a3 = a2 + kstep; const char* b3 = b2 + kstep;
            G_LDB(B0, 0, 0); G_SCHED; G_LDA(At, 0, 0); G_STAGE(G_SA(1, 1), a1 + hstepc, ld2c);
            G_WAIT_L(8); G_BAR; G_WAIT_L(0); G_MMA(0, 0, At, B0); G_BAR; G_SCHED;
            G_LDB(B1, 0, 1); G_STAGE(G_SB(0, 0), b2, ld2x);
            G_BAR; G_WAIT_L(0); G_MMA(0, 1, At, B1); G_BAR;
            G_LDA(At, 0, 1); G_STAGE(G_SA(0, 0), a2, ld2x);
            G_BAR; G_WAIT_L(0); G_MMA(1, 0, At, B0); G_BAR; G_SCHED;
            G_STAGE(G_SB(0, 1), b2 + hstepx, ld2x);
            G_WAIT_V(6); G_BAR; G_MMA(1, 1, At, B1); G_BAR;
            G_LDB(B0, 1, 0); G_SCHED; G_LDA(At, 1, 0); G_STAGE(G_SA(0, 1), a2 + hstepx, ld2x);
            G_WAIT_L(8); G_BAR; G_WAIT_L(0); G_MMA(0, 0, At, B0); G_BAR; G_SCHED;
            G_LDB(B1, 1, 1); G_STAGE(G_SB(1, 0), b3, ld2x);
            G_BAR; G_WAIT_L(0); G_MMA(0, 1, At, B1); G_BAR;
            G_LDA(At, 1, 1); G_STAGE(G_SA(1, 0), a3, ld2x);
            G_BAR; G_WAIT_L(0); G_MMA(1, 0, At, B0); G_BAR; G_SCHED;
            G_STAGE(G_SB(1, 1), b3 + hstepx, ld2x);
            G_WAIT_V(6); G_BAR; G_MMA(1, 1, At, B1); G_BAR;
        }
        E(acc, cur, wr, wc, fr, fq);
        if (!has_next) break;
        if (cur.fin) {
#pragma unroll
            for (int a = 0; a < 2; ++a)
#pragma unroll
                for (int b = 0; b < 2; ++b)
#pragma unroll
                    for (int m = 0; m < 4; ++m)
#pragma unroll
                        for (int n = 0; n < 2; ++n) acc[a][b][m][n] = (f32x4){0.f, 0.f, 0.f, 0.f};
        }
        cur = nxt; cA = nA; cB = nB; ++ui;
    }
    G_WAIT_V(0);
    if (wr == 0) G_BAR;
    G_BAR;
#undef G_SA
#undef G_SB
#undef G_STAGE
#undef G_LDA
#undef G_LDB
#undef G_MMA
}

#define EPI_LOOP_BN _Pragma("unroll") for (int bj = 0; bj < 2; ++bj) _Pragma("unroll") for (int n = 0; n < 2; ++n)
#define EPI_LOOP_AM _Pragma("unroll") for (int ai = 0; ai < 2; ++ai) _Pragma("unroll") for (int m = 0; m < 4; ++m)

__device__ __forceinline__ u32x4 pack8(const f32x4 a, const f32x4 b) { u32x4 w; w.x = cvt_pk_bf16(a[0], a[1]); w.y = cvt_pk_bf16(a[2], a[3]); w.z = cvt_pk_bf16(b[0], b[1]); w.w = cvt_pk_bf16(b[2], b[3]); return w; }
#define EPI_LOOP_B _Pragma("unroll") for (int bj = 0; bj < 2; ++bj)
#define EPI_LOOP_N _Pragma("unroll") for (int n = 0; n < 2; ++n)

struct EpiG1a {
    u16* mix; u16* vT; const float* bias; const float* lbl; int layer;
    __device__ __forceinline__ void operator()(f32x4 (&acc)[2][2][4][2], const Unit& u, int wr, int wc, int fr, int fq) const {
        const int type = u.pn >> 2;
        const int row0 = u.pm * 256 + wr * 64 + fr, colb = u.pn * 256 + wc * 32 + 8 * fq;
        f32x4 bvh[2][2], lbh[2][2];
        EPI_LOOP_B { EPI_LOOP_N { bvh[bj][n] = *(const f32x4*)(bias + colb + bj * 128 + 4 * n); lbh[bj][n] = (f32x4){0.f, 0.f, 0.f, 0.f}; } }
        if ((type == 3 || type == 4) && layer == 1) {
            const int dir = type - 3;
            EPI_LOOP_B { EPI_LOOP_N {
                const int cc = colb + bj * 128 - 3072 - dir * 1024 + 4 * n;
                const f32x4 l0 = *(const f32x4*)(lbl + dir * 1024 + cc), l1 = *(const f32x4*)(lbl + (2 + dir) * 1024 + cc);
#pragma unroll
                for (int e = 0; e < 4; ++e) lbh[bj][n][e] = sigm(l1[e] - l0[e]);
            } }
        }
        EPI_LOOP_B {
            const int c8 = colb + bj * 128;
            f32x4 bv[2], lb[2];
            EPI_LOOP_N { bv[n] = bvh[bj][n]; lb[n] = lbh[bj][n]; }
            EPI_LOOP_AM {
                const int r = row0 + ai * 128 + m * 16;
                f32x4 v[2];
                EPI_LOOP_N v[n] = acc[ai][bj][m][n] + bv[n];
                if (type == 7) {
                    const int b = r >> 14, s = r & 16383, hd = c8 - 7168;
                    EPI_LOOP_N {
#pragma unroll
                        for (int e = 0; e < 4; ++e) vT[((size_t)(b * 1024 + hd + 4 * n + e)) * 16384 + s] = f2bf(v[n][e]);
                    }
                } else {
                    u32x4 w;
                    if (type == 3 || type == 4) {
                        unsigned hw[2][2];
                        EPI_LOOP_N {
                            float o[4];
#pragma unroll
                            for (int e = 0; e < 4; ++e) { float f = lb[n][e] + (1.0f - lb[n][e]) * sigm(v[n][e]); f = fminf(fmaxf(f, 1e-6f), 1.0f); o[e] = __builtin_amdgcn_logf(f) * 0.69314718056f; }
                            hw[n][0] = (unsigned)f2h(o[0]) | ((unsigned)f2h(o[1]) << 16); hw[n][1] = (unsigned)f2h(o[2]) | ((unsigned)f2h(o[3]) << 16);
                        }
                        w.x = hw[0][0]; w.y = hw[0][1]; w.z = hw[1][0]; w.w = hw[1][1];
                    } else {
                        if (type == 0 || type == 2) {
                            EPI_LOOP_N {
#pragma unroll
                                for (int e = 0; e < 4; ++e) v[n][e] = silu(v[n][e]);
                            }
                        } else if (type == 5) { v[0] = v[0] * 0.08838834764831845f; v[1] = v[1] * 0.08838834764831845f; }
                        w = pack8(v[0], v[1]);
                    }
                    *(u32x4*)(mix + (size_t)r * NMIX + c8) = w;
                }
            }
        }
    }
};
struct EpiG1b {
    u16* gates; const float* bias;
    __device__ __forceinline__ void operator()(f32x4 (&acc)[2][2][4][2], const Unit& u, int wr, int wc, int fr, int fq) const {
        const int row0 = u.pm * 256 + wr * 64 + fr, colb = u.pn * 256 + wc * 32 + 8 * fq;
        f32x4 bvh[2][2];
        EPI_LOOP_B { EPI_LOOP_N bvh[bj][n] = *(const f32x4*)(bias + 8192 + colb + bj * 128 + 4 * n); }
        EPI_LOOP_B {
            const int c8 = colb + bj * 128;
            const f32x4 bv0 = bvh[bj][0], bv1 = bvh[bj][1];
            EPI_LOOP_AM {
                const int r = row0 + ai * 128 + m * 16;
                f32x4 v0 = acc[ai][bj][m][0] + bv0, v1 = acc[ai][bj][m][1] + bv1;
#pragma unroll
                for (int e = 0; e < 4; ++e) { v0[e] = sigm(v0[e]); v1[e] = sigm(v1[e]); }
                *(u32x4*)(gates + (size_t)r * 4096 + c8) = pack8(v0, v1);
            }
        }
    }
};
struct EpiG3 {
    const u16* gates; u16* merged;
    __device__ __forceinline__ void operator()(f32x4 (&acc)[2][2][4][2], const Unit& u, int wr, int wc, int fr, int fq) const {
        const int row0 = u.pm * 256 + wr * 64 + fr, colb = u.pn * 256 + wc * 32 + 8 * fq;
        EPI_LOOP_B {
            const int c8 = colb + bj * 128;
#pragma unroll
            for (int ai = 0; ai < 2; ++ai) {
                u32x4 gbw[4], gaw[4];
#pragma unroll
                for (int m = 0; m < 4; ++m) { const int r = row0 + ai * 128 + m * 16; gbw[m] = *(const u32x4*)(gates + (size_t)r * 4096 + 2048 + c8); }
                if (u.seg == 0) {
#pragma unroll
                    for (int m = 0; m < 4; ++m) { const int r = row0 + ai * 128 + m * 16; gaw[m] = *(const u32x4*)(gates + (size_t)r * 4096 + c8); }
#pragma unroll
                    for (int m = 0; m < 4; ++m) {
                        EPI_LOOP_N {
                            f32x4 v = acc[ai][bj][m][n];
                            v[0] *= bf_lo(gaw[m][2 * n]) * __builtin_amdgcn_rcpf(bf_lo(gbw[m][2 * n])); v[1] *= bf_hi(gaw[m][2 * n]) * __builtin_amdgcn_rcpf(bf_hi(gbw[m][2 * n]));
                            v[2] *= bf_lo(gaw[m][2 * n + 1]) * __builtin_amdgcn_rcpf(bf_lo(gbw[m][2 * n + 1])); v[3] *= bf_hi(gaw[m][2 * n + 1]) * __builtin_amdgcn_rcpf(bf_hi(gbw[m][2 * n + 1]));
                            acc[ai][bj][m][n] = v;
                        }
                    }
                } else {
#pragma unroll
                    for (int m = 0; m < 4; ++m) {
                        const int r = row0 + ai * 128 + m * 16;
                        f32x4 v[2];
                        EPI_LOOP_N { v[n] = acc[ai][bj][m][n]; v[n][0] *= bf_lo(gbw[m][2 * n]); v[n][1] *= bf_hi(gbw[m][2 * n]); v[n][2] *= bf_lo(gbw[m][2 * n + 1]); v[n][3] *= bf_hi(gbw[m][2 * n + 1]); }
                        *(u32x4*)(merged + (size_t)r * 2048 + c8) = pack8(v[0], v[1]);
                    }
                }
            }
        }
    }
};
template <int LN> struct EpiG4 {
    const float* xres; float* y; const float* stats; const float* g; const float* b;
    __device__ __forceinline__ void operator()(f32x4 (&acc)[2][2][4][2], const Unit& u, int wr, int wc, int fr, int fq) const {
        const int row0 = u.pm * 256 + wr * 64 + fr, colb = u.pn * 256 + wc * 32 + 8 * fq;
        f32x4 xr[2][4], gv[2], bv[2]; f32x2 st[2][4];
#define G4_LOAD(k) do { const int ai_ = (k) >> 2, c_ = colb + (((k) >> 1) & 1) * 128 + 4 * ((k) & 1); \
            if (LN) { gv[(k) & 1] = *(const f32x4*)(g + c_); bv[(k) & 1] = *(const f32x4*)(b + c_); } \
            _Pragma("unroll") for (int m = 0; m < 4; ++m) { const int r_ = row0 + ai_ * 128 + m * 16; xr[(k) & 1][m] = *(const f32x4*)(xres + (size_t)r_ * 2048 + c_); \
                if (LN) st[(k) & 1][m] = *(const f32x2*)(stats + 2 * r_); } } while (0)
        G4_LOAD(0);
#pragma unroll
        for (int k = 0; k < 8; ++k) {
            if (k < 7) G4_LOAD(k + 1);
            const int ai = k >> 2, bj = (k >> 1) & 1, n = k & 1, c = colb + bj * 128 + 4 * n;
#pragma unroll
            for (int m = 0; m < 4; ++m) {
                f32x4 x = xr[k & 1][m];
                if (LN) x = (x - st[k & 1][m][0]) * st[k & 1][m][1] * gv[k & 1] + bv[k & 1];
                *(f32x4*)(y + (size_t)(row0 + ai * 128 + m * 16) * 2048 + c) = x * ALPHA + acc[ai][bj][m][n];
            }
        }
#undef G4_LOAD
    }
};
struct EpiG6 {
    u16* h; u16* sg;
    __device__ __forceinline__ void operator()(f32x4 (&acc)[2][2][4][2], const Unit& u, int wr, int wc, int fr, int fq) const {
        const int row0 = u.pm * 256 + wr * 64 + fr;
        if (u.pn < 44) {
            const int hc = u.pn * 128 + wc * 32 + 8 * fq;
            EPI_LOOP_AM {
                const int r = row0 + ai * 128 + m * 16;
                f32x4 o0, o1;
#pragma unroll
                for (int e = 0; e < 4; ++e) { o0[e] = silu(acc[ai][0][m][0][e]) * acc[ai][0][m][1][e]; o1[e] = silu(acc[ai][1][m][0][e]) * acc[ai][1][m][1][e]; }
                *(u32x4*)(h + (size_t)r * FH + hc) = pack8(o0, o1);
            }
        } else {
            const int colb = (u.pn - 44) * 256 + wc * 32 + 8 * fq;
            EPI_LOOP_B {
                const int c8 = colb + bj * 128;
                EPI_LOOP_AM {
                    const int r = row0 + ai * 128 + m * 16;
                    f32x4 v0 = acc[ai][bj][m][0], v1 = acc[ai][bj][m][1];
#pragma unroll
                    for (int e = 0; e < 4; ++e) { v0[e] = sigm(v0[e]); v1[e] = sigm(v1[e]); }
                    *(u32x4*)(sg + (size_t)r * 2048 + c8) = pack8(v0, v1);
                }
            }
        }
    }
};
struct EpiG7 {
    const u16* sg; float* y; const float* stats; const float* g; const float* b;
    __device__ __forceinline__ void operator()(f32x4 (&acc)[2][2][4][2], const Unit& u, int wr, int wc, int fr, int fq) const {
        const int row0 = u.pm * 256 + wr * 64 + fr, colb = u.pn * 256 + wc * 32 + 8 * fq;
        if (u.seg == 0) {
            EPI_LOOP_B {
                const int c8 = colb + bj * 128;
                u32x4 sv[2][4];
                EPI_LOOP_AM { const int r = row0 + ai * 128 + m * 16; sv[ai][m] = *(const u32x4*)(sg + (size_t)r * 2048 + c8); }
                EPI_LOOP_AM {
                    EPI_LOOP_N {
                        f32x4 v = acc[ai][bj][m][n];
                        v[0] *= bf_lo(sv[ai][m][2 * n]); v[1] *= bf_hi(sv[ai][m][2 * n]); v[2] *= bf_lo(sv[ai][m][2 * n + 1]); v[3] *= bf_hi(sv[ai][m][2 * n + 1]);
                        acc[ai][bj][m][n] = v;
                    }
                }
            }
        } else {
#pragma unroll
            for (int ai = 0; ai < 2; ++ai) {
                f32x2 st[4];
#pragma unroll
                for (int m = 0; m < 4; ++m) st[m] = *(const f32x2*)(stats + 2 * (row0 + ai * 128 + m * 16));
                EPI_LOOP_BN {
                    const int c = colb + bj * 128 + 4 * n;
                    const f32x4 gv = *(const f32x4*)(g + c), bv = *(const f32x4*)(b + c);
                    f32x4 xr[4];
#pragma unroll
                    for (int m = 0; m < 4; ++m) xr[m] = *(const f32x4*)(y + (size_t)(row0 + ai * 128 + m * 16) * 2048 + c);
#pragma unroll
                    for (int m = 0; m < 4; ++m) {
                        const f32x4 x1 = (xr[m] - st[m][0]) * st[m][1] * gv + bv;
                        *(f32x4*)(y + (size_t)(row0 + ai * 128 + m * 16) * 2048 + c) = x1 * ALPHA + acc[ai][bj][m][n];
                    }
                }
            }
        }
    }
};

template <int PERM>
__device__ __forceinline__ void convT(const float* src, int ldsrc, int K, int N, u16* dst, LAS float* tl, const int tid, const int bid) {
    const int nkt = K >> 6, nnt = N >> 7;
    for (int T = bid; T < nkt * nnt; T += gridDim.x) {
        const int kt = T % nkt, ntile = T / nkt; const int k0 = kt << 6, n0 = ntile << 7;
        const int nn = tid & 127; const int rho = n0 + nn;
        int sc;
        if (PERM) { const int R = rho & 255; const int j = (rho >> 8) * 128 + 32 * ((R >> 5) & 3) + 8 * ((R >> 2) & 3) + 4 * (R >> 7) + (R & 3); sc = ((R >> 4) & 1) ? FH + j : j; }
        else { const int q = rho & 31; sc = (rho & ~31) + 8 * ((q & 15) >> 2) + 4 * (q >> 4) + (q & 3); }
        float ld[16];
#pragma unroll
        for (int i = 0; i < 16; ++i) ld[i] = src[(size_t)(k0 + (tid >> 7) + 4 * i) * ldsrc + sc];
#pragma unroll
        for (int i = 0; i < 16; ++i) tl[((tid >> 7) + 4 * i) * 129 + nn] = ld[i];
        __syncthreads();
        const int n2 = tid >> 2, k16 = (tid & 3) << 4;
        float v[16];
#pragma unroll
        for (int j = 0; j < 16; ++j) v[j] = tl[(k16 + j) * 129 + n2];
        u32x4 w0, w1;
#pragma unroll
        for (int j = 0; j < 4; ++j) { w0[j] = cvt_pk_bf16(v[2 * j], v[2 * j + 1]); w1[j] = cvt_pk_bf16(v[8 + 2 * j], v[9 + 2 * j]); }
        u16* dp = dst + (size_t)(n0 + n2) * K + k0 + k16;
        *(u32x4*)dp = w0; *(u32x4*)(dp + 8) = w1;
        __syncthreads();
    }
}
__device__ __forceinline__ void cvt_flat(const float* src, u16* dst, size_t n4, const int tid, const int bid) {
    const size_t stride = (size_t)gridDim.x * 512;
    size_t i = (size_t)bid * 512 + tid;
    for (; i + 3 * stride < n4; i += 4 * stride) {
        f32x4 v[4];
#pragma unroll
        for (int j = 0; j < 4; ++j) v[j] = *(const f32x4*)(src + (i + j * stride) * 4);
#pragma unroll
        for (int j = 0; j < 4; ++j) { u32x2 w; w.x = cvt_pk_bf16(v[j][0], v[j][1]); w.y = cvt_pk_bf16(v[j][2], v[j][3]); *(u32x2*)(dst + (i + j * stride) * 4) = w; }
    }
    for (; i < n4; i += stride) {
        const f32x4 v = *(const f32x4*)(src + i * 4);
        u32x2 w; w.x = cvt_pk_bf16(v[0], v[1]); w.y = cvt_pk_bf16(v[2], v[3]);
        *(u32x2*)(dst + i * 4) = w;
    }
}
__device__ __forceinline__ void conv_A(const P& p, unsigned char* ws, int l, LAS unsigned char* lds, const int tid, const int bid) {
    LAS float* tl = (LAS float*)lds;
    convT<0>(p.w_in + (size_t)l * 2048 * 12288, 12288, 2048, 12288, (u16*)(ws + OFF_WIN), tl, tid, bid);
    convT<0>(p.w_branch + (size_t)(l * 2 + 0) * 1024 * 2048, 2048, 1024, 2048, (u16*)(ws + OFF_WBR), tl, tid, bid);
    convT<0>(p.w_branch + (size_t)(l * 2 + 1) * 1024 * 2048, 2048, 1024, 2048, (u16*)(ws + OFF_WBR) + 2048 * 1024, tl, tid, bid);
    convT<0>(p.w_out + (size_t)l * 2048 * 2048, 2048, 2048, 2048, (u16*)(ws + OFF_WOUT), tl, tid, bid);
}
__device__ __forceinline__ void conv_B(const P& p, unsigned char* ws, int l, LAS unsigned char* lds, const int tid, const int bid) {
    LAS float* tl = (LAS float*)lds;
    convT<1>(p.w_up + (size_t)l * 2048 * 11264, 11264, 2048, 11264, (u16*)(ws + OFF_WUPG), tl, tid, bid);
    convT<0>(p.w_pg + (size_t)l * 2048 * 2048, 2048, 2048, 2048, (u16*)(ws + OFF_WUPG) + (size_t)11264 * 2048, tl, tid, bid);
    convT<0>(p.w_down + (size_t)l * FH * 2048, 2048, FH, 2048, (u16*)(ws + OFF_WDOWN), tl, tid, bid);
    convT<0>(p.w_pe + (size_t)l * 256 * 2048, 2048, 256, 2048, (u16*)(ws + OFF_WPE), tl, tid, bid);
    cvt_flat(p.p + (size_t)l * M_ * 256, (u16*)(ws + OFF_PB), (size_t)M_ * 256 / 4, tid, bid);
}

template <int FULL>
__device__ __forceinline__ void ln_phase(float* y, const float* g, const float* b, u16* xb, float* stats, const int tid, const int bid) {
    constexpr int NR = 4;
    const int lane = tid & 63, wid = tid >> 6;
    const int nw = (int)gridDim.x * 8;
    for (int row0 = bid * 8 + wid; row0 < M_; row0 += NR * nw) {
        f32x4 v[NR][8]; float s[NR], q[NR];
#pragma unroll
        for (int k = 0; k < NR; ++k) { const int row = min(row0 + k * nw, M_ - 1); const float* yp = y + (size_t)row * 2048 + lane * 4;
#pragma unroll
            for (int i = 0; i < 8; ++i) v[k][i] = *(const f32x4*)(yp + i * 256); }
#pragma unroll
        for (int k = 0; k < NR; ++k) { s[k] = 0.f;
#pragma unroll
            for (int i = 0; i < 8; ++i) s[k] += (v[k][i][0] + v[k][i][1]) + (v[k][i][2] + v[k][i][3]); }
#pragma unroll
        for (int o = 32; o >= 1; o >>= 1)
#pragma unroll
            for (int k = 0; k < NR; ++k) s[k] += shx(s[k], o, lane);
#pragma unroll
        for (int k = 0; k < NR; ++k) { s[k] *= (1.0f / 2048.0f); q[k] = 0.f;
#pragma unroll
            for (int i = 0; i < 8; ++i) { const f32x4 d = v[k][i] - s[k]; q[k] += (d[0] * d[0] + d[1] * d[1]) + (d[2] * d[2] + d[3] * d[3]); } }
#pragma unroll
        for (int o = 32; o >= 1; o >>= 1)
#pragma unroll
            for (int k = 0; k < NR; ++k) q[k] += shx(q[k], o, lane);
#pragma unroll
        for (int k = 0; k < NR; ++k) q[k] = rsqrtf(q[k] * (1.0f / 2048.0f) + 1e-5f);
#pragma unroll
        for (int i = 0; i < 8; ++i) {
            const f32x4 gv = *(const f32x4*)(g + i * 256 + lane * 4), bv = *(const f32x4*)(b + i * 256 + lane * 4);
#pragma unroll
            for (int k = 0; k < NR; ++k) {
                const int row = row0 + k * nw;
                if (row < M_) {
                    const f32x4 o = (v[k][i] - s[k]) * q[k] * gv + bv;
                    if (FULL) *(f32x4*)(y + (size_t)row * 2048 + lane * 4 + i * 256) = o;
                    else if (i == 0 && lane == 0) *(f32x2*)(stats + 2 * row) = (f32x2){s[k], q[k]};
                    u32x2 w; w.x = cvt_pk_bf16(o[0], o[1]); w.y = cvt_pk_bf16(o[2], o[3]);
                    *(u32x2*)(xb + (size_t)row * 2048 + i * 256 + lane * 4) = w;
                }
            }
        }
    }
}

__device__ __forceinline__ void post_phase(const P& p, unsigned char* ws, int l, const int tid, const int bid) {
    u16* ofw = (u16*)(ws + OFF_OFW); const u16* obw = (const u16*)(ws + OFF_OBW); const u16* mix = (const u16*)(ws + OFF_MIX);
    const float* ng = p.ang + l * 1024;
    const int lane = tid & 63, wid = tid >> 6;
    const int nw = (int)gridDim.x * 8, NWI = M_ * 8 / 4;
    for (int wi0 = bid * 8 + wid; wi0 < NWI; wi0 += 4 * nw) {
        u32x4 a[4], bq[4], gt[4];
#pragma unroll
        for (int k = 0; k < 4; ++k) {
            const int wi = min(wi0 + k * nw, NWI - 1);
            const int idx = wi * 4 + (lane >> 4); const int tok = idx >> 3, hh = idx & 7, e0 = (lane & 15) * 8;
            a[k] = *(const u32x4*)(ofw + (size_t)tok * 1024 + hh * 128 + e0); bq[k] = *(const u32x4*)(obw + (size_t)tok * 1024 + hh * 128 + e0);
            gt[k] = *(const u32x4*)(mix + (size_t)tok * NMIX + 2048 + hh * 128 + e0);
        }
#pragma unroll
        for (int k = 0; k < 4; ++k) {
            const int wi = wi0 + k * nw;
            const int idx = wi * 4 + (lane >> 4); const int tok = idx >> 3, hh = idx & 7, e0 = (lane & 15) * 8;
            float o[8];
#pragma unroll
            for (int j = 0; j < 4; ++j) { o[2 * j] = bf_lo(a[k][j]) + bf_lo(bq[k][j]); o[2 * j + 1] = bf_hi(a[k][j]) + bf_hi(bq[k][j]); }
            float ss = 0.f;
#pragma unroll
            for (int j = 0; j < 8; ++j) ss += o[j] * o[j];
            ss += shx(ss, 1, lane); ss += shx(ss, 2, lane); ss += shx(ss, 4, lane); ss += shx(ss, 8, lane);
            const float rs = rsqrtf(ss * (1.0f / 128.0f) + 1e-6f);
            const f32x4 g0 = *(const f32x4*)(ng + hh * 128 + e0), g1 = *(const f32x4*)(ng + hh * 128 + e0 + 4);
            u32x4 w;
#pragma unroll
            for (int j = 0; j < 4; ++j) {
                const float gl = (j < 2) ? g0[2 * j] : g1[2 * j - 4], gh = (j < 2) ? g0[2 * j + 1] : g1[2 * j - 3];
                w[j] = cvt_pk_bf16(o[2 * j] * rs * gl * bf_lo(gt[k][j]), o[2 * j + 1] * rs * gh * bf_hi(gt[k][j]));
            }
            if (wi < NWI) *(u32x4*)(ofw + (size_t)tok * 1024 + hh * 128 + e0) = w;
        }
    }
}

constexpr int R_QG = 0, R_QM = 17408, R_KM = 34816, R_KDT = 52224, R_VT = 70656, R_ATT = 89088, R_DV = 98304, R_TOT = 98816;
__device__ __forceinline__ void rec1_phase(unsigned char* ws, LAS unsigned char* lds, const int tid, const int item) {
    const int wid = __builtin_amdgcn_readfirstlane(tid >> 6), lane = tid & 63;
    const int seq = item & 31, grp = item >> 5; const int dir = seq & 1, hh = (seq >> 1) & 7, b = seq >> 4;
    const u16* mix = (const u16*)(ws + OFF_MIX);
    u16* odir = (u16*)(ws + (dir ? OFF_OBW : OFF_OFW));
    const int sg = wid, c2 = 2 * lane;
    const int r = lane & 31, h = lane >> 5;
    const int kcp = (c2 & ~15) + 8 * ((c2 >> 2) & 1) + 4 * ((c2 >> 3) & 1) + (c2 & 3);
    LAS float* TOT = (LAS float*)(lds + R_TOT); LAS float* DV = (LAS float*)(lds + R_DV);
    f32x16 S[4];
#pragma unroll
    for (int kb = 0; kb < 4; ++kb)
#pragma unroll
        for (int e = 0; e < 16; ++e) S[kb][e] = 0.f;
    unsigned nlf[8], nq[8], nv[8];
    {
        const int co = dir ? 255 - grp * 32 : grp * 32; const size_t tok0 = (size_t)b * S_ + (size_t)co * 64;
#pragma unroll
        for (int i = 0; i < 8; ++i) { const int tau = 8 * sg + i, t = dir ? 63 - tau : tau; const u16* rp = mix + (tok0 + t) * NMIX + hh * 128 + c2;
            nlf[i] = *(const unsigned*)(rp + 3072 + dir * 1024); nq[i] = *(const unsigned*)(rp); nv[i] = *(const unsigned*)(rp + 1024); }
    }
    float gpre0 = 0.f, gpre1 = 0.f;
    float* GPRE = (float*)(ws + OFF_GPRE);
    for (int c = grp * 32; c < grp * 32 + 32; ++c) {
        const int co = dir ? 255 - c : c; const size_t tok0 = (size_t)b * S_ + (size_t)co * 64;
        float g0[8], g1[8]; float cs0 = 0.f, cs1 = 0.f;
#pragma unroll
        for (int i = 0; i < 8; ++i) { cs0 += h2f((u16)(nlf[i] & 0xffffu)); cs1 += h2f((u16)(nlf[i] >> 16)); g0[i] = cs0; g1[i] = cs1; }
        TOT[sg * 128 + c2] = cs0; TOT[sg * 128 + c2 + 1] = cs1;
        __syncthreads();
        float pre0 = 0.f, pre1 = 0.f, ref0 = 0.f, ref1 = 0.f, gl0 = 0.f, gl1 = 0.f;
#pragma unroll
        for (int s = 0; s < 8; ++s) {
            const float a0 = TOT[s * 128 + c2], a1 = TOT[s * 128 + c2 + 1];
            if (s < sg) { pre0 += a0; pre1 += a1; }
            if (s < 4) { ref0 += a0; ref1 += a1; }
            gl0 += a0; gl1 += a1;
        }
        float kd0[8], kd1[8];
#pragma unroll
        for (int i = 0; i < 8; ++i) {
            const float gi0 = pre0 + g0[i], gi1 = pre1 + g1[i];
            const float kk0 = 1.0f - fexp(h2f((u16)(nlf[i] & 0xffffu))), kk1 = 1.0f - fexp(h2f((u16)(nlf[i] >> 16)));
            const float q0 = bf_lo(nq[i]), q1 = bf_hi(nq[i]);
            kd0[i] = kk0 * fexp(gl0 - gi0); kd1[i] = kk1 * fexp(gl1 - gi1);
            const int tau = 8 * sg + i, t = dir ? 63 - tau : tau;
            *(LAS unsigned*)(lds + R_QG + t * 272 + kcp * 2) = cvt_pk_bf16(q0 * fexp(gi0), q1 * fexp(gi1));
            *(LAS unsigned*)(lds + R_QM + t * 272 + c2 * 2) = cvt_pk_bf16(q0 * fexp(fminf(gi0 - ref0, 80.f)), q1 * fexp(fminf(gi1 - ref1, 80.f)));
            *(LAS unsigned*)(lds + R_KM + t * 272 + c2 * 2) = cvt_pk_bf16(kk0 * fexp(fminf(ref0 - gi0, 80.f)), kk1 * fexp(fminf(ref1 - gi1, 80.f)));
        }
        {
            u32x4 w0, w1, x0, x1;
#pragma unroll
            for (int j = 0; j < 4; ++j) {
                w0[j] = dir ? cvt_pk_bf16(kd0[7 - 2 * j], kd0[6 - 2 * j]) : cvt_pk_bf16(kd0[2 * j], kd0[2 * j + 1]);
                w1[j] = dir ? cvt_pk_bf16(kd1[7 - 2 * j], kd1[6 - 2 * j]) : cvt_pk_bf16(kd1[2 * j], kd1[2 * j + 1]);
                const unsigned va = dir ? nv[7 - 2 * j] : nv[2 * j], vb = dir ? nv[6 - 2 * j] : nv[2 * j + 1];
                x0[j] = (va & 0xffffu) | (vb << 16);
                x1[j] = (va >> 16) | (vb & 0xffff0000u);
            }
            const int tb0 = dir ? 56 - 8 * sg : 8 * sg;
            *(LAS u32x4*)(lds + R_KDT + c2 * 144 + tb0 * 2) = w0; *(LAS u32x4*)(lds + R_KDT + (c2 + 1) * 144 + tb0 * 2) = w1;
            *(LAS u32x4*)(lds + R_VT + c2 * 144 + tb0 * 2) = x0; *(LAS u32x4*)(lds + R_VT + (c2 + 1) * 144 + tb0 * 2) = x1;
        }
        if (sg == 0) { DV[c2] = fexp(gl0); DV[c2 + 1] = fexp(gl1); GPRE[(size_t)(seq * 256 + c) * 128 + c2] = gpre0; GPRE[(size_t)(seq * 256 + c) * 128 + c2 + 1] = gpre1; }
        gpre0 += gl0; gpre1 += gl1;
        __syncthreads();
        if (c + 1 < grp * 32 + 32) {
            const int cn = dir ? 254 - c : c + 1; const size_t tokn = (size_t)b * S_ + (size_t)cn * 64;
#pragma unroll
            for (int i = 0; i < 8; ++i) { const int tau = 8 * sg + i, t = dir ? 63 - tau : tau; const u16* rp = mix + (tokn + t) * NMIX + hh * 128 + c2;
                nlf[i] = *(const unsigned*)(rp + 3072 + dir * 1024); nq[i] = *(const unsigned*)(rp); nv[i] = *(const unsigned*)(rp + 1024); }
        }
        if (wid < 4) {
            const int sb = wid & 1, tb = wid >> 1;
            f32x16 a;
#pragma unroll
            for (int e = 0; e < 16; ++e) a[e] = 0.f;
#pragma unroll
            for (int s8 = 0; s8 < 8; ++s8) {
                const bf16x8 A = *(const LAS bf16x8*)(lds + R_KM + (32 * sb + r) * 272 + (16 * s8 + 8 * h) * 2);
                const bf16x8 B = *(const LAS bf16x8*)(lds + R_QM + (32 * tb + r) * 272 + (16 * s8 + 8 * h) * 2);
                a = __builtin_amdgcn_mfma_f32_32x32x16_bf16(A, B, a, 0, 0, 0);
            }
            const int tau = 32 * tb + r;
#pragma unroll
            for (int gq = 0; gq < 4; ++gq) {
                const int sbase = 32 * sb + 8 * gq + 4 * h;
                float o[4];
#pragma unroll
                for (int e = 0; e < 4; ++e) { const int sig = sbase + e; const bool keep = dir ? (sig >= tau) : (sig <= tau); o[e] = keep ? a[4 * gq + e] : 0.f; }
                u32x2 w; w.x = cvt_pk_bf16(o[0], o[1]); w.y = cvt_pk_bf16(o[2], o[3]);
                *(LAS u32x2*)(lds + R_ATT + tau * 144 + sbase * 2) = w;
            }
        }
        __syncthreads();
        if (wid < 4) {
            const int vs = wid;
            bf16x8 Bv[4];
#pragma unroll
            for (int s = 0; s < 4; ++s) Bv[s] = *(const LAS bf16x8*)(lds + R_VT + (32 * vs + r) * 144 + (16 * s + 8 * h) * 2);
            bf16x8 Sb[4][2];
#pragma unroll
            for (int kb = 0; kb < 4; ++kb)
#pragma unroll
                for (int s = 0; s < 2; ++s) {
                    u32x4 w;
#pragma unroll
                    for (int j = 0; j < 4; ++j) w[j] = cvt_pk_bf16(S[kb][8 * s + 2 * j], S[kb][8 * s + 2 * j + 1]);
                    Sb[kb][s] = __builtin_bit_cast(bf16x8, w);
                }
#pragma unroll
            for (int tb = 0; tb < 2; ++tb) {
                f32x16 o;
#pragma unroll
                for (int e = 0; e < 16; ++e) o[e] = 0.f;
#pragma unroll
                for (int kb = 0; kb < 4; ++kb)
#pragma unroll
                    for (int s = 0; s < 2; ++s) {
                        const bf16x8 A = *(const LAS bf16x8*)(lds + R_QG + (32 * tb + r) * 272 + (32 * kb + 16 * s + 8 * h) * 2);
                        o = __builtin_amdgcn_mfma_f32_32x32x16_bf16(A, Sb[kb][s], o, 0, 0, 0);
                    }
#pragma unroll
                for (int s = 0; s < 4; ++s) {
                    const bf16x8 A = *(const LAS bf16x8*)(lds + R_ATT + (32 * tb + r) * 144 + (16 * s + 8 * h) * 2);
                    o = __builtin_amdgcn_mfma_f32_32x32x16_bf16(A, Bv[s], o, 0, 0, 0);
                }
#pragma unroll
                for (int e = 0; e < 16; ++e) {
                    const int t = 32 * tb + (e & 3) + 8 * (e >> 2) + 4 * h;
                    odir[(tok0 + t) * 1024 + hh * 128 + 32 * vs + r] = f2bf(o[e]);
                }
            }
#pragma unroll
            for (int kb = 0; kb < 4; ++kb) {
#pragma unroll
                for (int gq = 0; gq < 4; ++gq) {
                    const f32x4 d4 = *(const LAS f32x4*)(lds + R_DV + (32 * kb + 8 * gq + 4 * h) * 4);
#pragma unroll
                    for (int e = 0; e < 4; ++e) S[kb][4 * gq + e] *= d4[e];
                }
#pragma unroll
                for (int s = 0; s < 4; ++s) {
                    const bf16x8 A = *(const LAS bf16x8*)(lds + R_KDT + (32 * kb + r) * 144 + (16 * s + 8 * h) * 2);
                    S[kb] = __builtin_amdgcn_mfma_f32_32x32x16_bf16(A, Bv[s], S[kb], 0, 0, 0);
                }
            }
        }
        __syncthreads();
    }
    if (wid < 4) {
        float* sg_out = (float*)(ws + OFF_SGRP) + (size_t)(seq * 8 + grp) * 16384;
#pragma unroll
        for (int kb = 0; kb < 4; ++kb)
#pragma unroll
            for (int e = 0; e < 16; ++e) sg_out[(32 * kb + (e & 3) + 8 * (e >> 2) + 4 * h) * 128 + 32 * wid + r] = S[kb][e];
    }
    if (sg == 0) { float* gt = (float*)(ws + OFF_GTOT) + (size_t)(seq * 8 + grp) * 128; gt[c2] = gpre0; gt[c2 + 1] = gpre1; }
}

__device__ __forceinline__ void rec2_phase(unsigned char* ws, const int tid, const int bid) {
    const float* sgrp = (const float*)(ws + OFF_SGRP); const float* gtot = (const float*)(ws + OFF_GTOT); u16* sint = (u16*)(ws + OFF_SINT);
    for (int idx = bid * 512 + tid; idx < 32 * 16384; idx += (int)gridDim.x * 512) {
        const int seq = idx >> 14, k = (idx >> 7) & 127, v = idx & 127;
        float sgv[8], gtv[8];
#pragma unroll
        for (int g = 0; g < 8; ++g) { sgv[g] = sgrp[(size_t)(seq * 8 + g) * 16384 + k * 128 + v]; gtv[g] = gtot[(seq * 8 + g) * 128 + k]; }
        float sin = 0.f;
#pragma unroll
        for (int g = 0; g < 8; ++g) {
            sint[((size_t)(seq * 8 + g) * 128 + v) * 128 + k] = f2bf(sin);
            sin = fexp(gtv[g]) * sin + sgv[g];
        }
    }
}

constexpr int R3_QC = 0, R3_TOT = 17408;
__device__ __forceinline__ void rec3_phase(unsigned char* ws, LAS unsigned char* lds, const int tid, const int bid) {
    const int wid = __builtin_amdgcn_readfirstlane(tid >> 6), lane = tid & 63;
    const u16* mix = (const u16*)(ws + OFF_MIX);
    const float* GPRE = (const float*)(ws + OFF_GPRE);
    const int sg = wid, c2 = 2 * lane, r = lane & 31, h = lane >> 5;
    LAS float* TOT = (LAS float*)(lds + R3_TOT);
    for (int u = bid; u < 32 * 224; u += (int)gridDim.x) {
        const int seq = u & 31, c = 32 + (u >> 5), grp = c >> 5;
        const int dir = seq & 1, hh = (seq >> 1) & 7, b = seq >> 4;
        const int co = dir ? 255 - c : c; const size_t tok0 = (size_t)b * S_ + (size_t)co * 64;
        u16* odir = (u16*)(ws + (dir ? OFF_OBW : OFF_OFW));
        const float gp0 = GPRE[(size_t)(seq * 256 + c) * 128 + c2], gp1 = GPRE[(size_t)(seq * 256 + c) * 128 + c2 + 1];
        if (__all((gp0 < -87.5f) && (gp1 < -87.5f))) continue;
        unsigned nlf[8], nq[8];
#pragma unroll
        for (int i = 0; i < 8; ++i) { const int tau = 8 * sg + i, t = dir ? 63 - tau : tau; const u16* rp = mix + (tok0 + t) * NMIX + hh * 128 + c2;
            nlf[i] = *(const unsigned*)(rp + 3072 + dir * 1024); nq[i] = *(const unsigned*)(rp); }
        float g0[8], g1[8]; float cs0 = 0.f, cs1 = 0.f;
#pragma unroll
        for (int i = 0; i < 8; ++i) { cs0 += h2f((u16)(nlf[i] & 0xffffu)); cs1 += h2f((u16)(nlf[i] >> 16)); g0[i] = cs0; g1[i] = cs1; }
        TOT[sg * 128 + c2] = cs0; TOT[sg * 128 + c2 + 1] = cs1;
        __syncthreads();
        float pre0 = gp0, pre1 = gp1;
#pragma unroll
        for (int s = 0; s < 8; ++s) { if (s < sg) { pre0 += TOT[s * 128 + c2]; pre1 += TOT[s * 128 + c2 + 1]; } }
#pragma unroll
        for (int i = 0; i < 8; ++i) {
            const int tau = 8 * sg + i, t = dir ? 63 - tau : tau;
            *(LAS unsigned*)(lds + R3_QC + t * 272 + c2 * 2) = cvt_pk_bf16(bf_lo(nq[i]) * fexp(pre0 + g0[i]), bf_hi(nq[i]) * fexp(pre1 + g1[i]));
        }
        __syncthreads();
        {
            const int tb = wid & 1, vq = wid >> 1;
            const u16* sin = (const u16*)(ws + OFF_SINT) + ((size_t)(seq * 8 + grp) * 128 + 32 * vq + r) * 128 + 8 * h;
            f32x16 o;
#pragma unroll
            for (int e = 0; e < 16; ++e) o[e] = 0.f;
#pragma unroll
            for (int s = 0; s < 8; ++s) {
                const bf16x8 A = *(const LAS bf16x8*)(lds + R3_QC + (32 * tb + r) * 272 + (16 * s + 8 * h) * 2);
                const bf16x8 B = *(const bf16x8*)(sin + 16 * s);
                o = __builtin_amdgcn_mfma_f32_32x32x16_bf16(A, B, o, 0, 0, 0);
            }
            u16* op0 = odir + (tok0 + 32 * tb + 4 * h) * 1024 + hh * 128 + 32 * vq + r;
            u16 old[16];
#pragma unroll
            for (int e = 0; e < 16; ++e) old[e] = op0[((e & 3) + 8 * (e >> 2)) * 1024];
#pragma unroll
            for (int e = 0; e < 16; ++e) op0[((e & 3) + 8 * (e >> 2)) * 1024] = f2bf(bf2f(old[e]) + o[e]);
        }
        __syncthreads();
    }
}

__device__ __forceinline__ void na_phase(const P& p, unsigned char* ws, int l, LAS unsigned char* lds, int blk0, const int tid, const int bid) {
    const int wid = tid >> 6, lane = tid & 63, q15 = lane & 15, g = lane >> 4;
    LAS float* rp = (LAS float*)(lds + 256);
    for (int i = tid; i < 3720; i += 512) rp[i] = p.rpb[l * 3720 + i];
    __syncthreads();
    const u16* mix = (const u16*)(ws + OFF_MIX); const u16* vT = (const u16*)(ws + OFF_VT); u16* ob = (u16*)(ws + OFF_OB);
    const int nw = ((int)gridDim.x - blk0) * 8;
    const int lb = (((bid - blk0) & 7) * (((int)gridDim.x - blk0) >> 3)) + ((bid - blk0) >> 3);
    for (int item = ((((int)gridDim.x - blk0) & 7) == 0 ? lb : (bid - blk0)) * 8 + wid; item < 16384; item += nw) {
        const int j = item & 3, hh = (item >> 2) & 7, r = (item >> 5) & 255, b = item >> 13;
        const int base = b * S_;
        const int rs = min(max(r - 4, 0), 248), c0 = min(max(16 * j - 8, 0), 32);
        const int tq = base + r * 64 + 16 * j + q15;
        bf16x8 Qf[4];
#pragma unroll
        for (int ks = 0; ks < 4; ++ks) Qf[ks] = *(const bf16x8*)(mix + (size_t)tq * NMIX + 5120 + hh * 128 + 32 * ks + 8 * g);
        const u16* kbase = mix + ((size_t)(base + rs * 64 + c0 + 8 * (q15 >> 2) + (q15 & 3))) * NMIX + 6144 + hh * 128 + 8 * g;
        const u16* vbase = vT + ((size_t)((b * 8 + hh) * 128 + q15)) * 16384 + rs * 64 + c0 + 8 * g;
        bf16x8 KB[2][16];
#define NA_LOADK(bt) do { _Pragma("unroll") for (int tt = 0; tt < 4; ++tt) _Pragma("unroll") for (int ks = 0; ks < 4; ++ks) { const int t_ = 4 * (bt) + tt; \
            KB[(bt) & 1][tt * 4 + ks] = *(const bf16x8*)(kbase + (size_t)((t_ >> 1) * 64 + 4 * (t_ & 1)) * NMIX + 32 * ks); } } while (0)
#define NA_LOADV(vb) do { _Pragma("unroll") for (int dd = 0; dd < 2; ++dd) _Pragma("unroll") for (int kk = 0; kk < 8; ++kk) \
            VB[(vb) & 1][dd * 8 + kk] = *(const bf16x8*)(vbase + (size_t)(16 * (2 * (vb) + dd)) * 16384 + kk * 64); } while (0)
        f32x4 st[16];
        NA_LOADK(0); NA_LOADK(1);
        const int cq = 16 * j + q15, cs = min(max(cq - 8, 0), 48);
        const LAS float* rb0 = rp + hh * 465 + (rs - r + 7) * 31 + (c0 + 8 * g - cq + 15);
        __builtin_amdgcn_sched_barrier(0);
#pragma unroll
        for (int bt = 0; bt < 4; ++bt) {
#pragma unroll
            for (int tt = 0; tt < 4; ++tt) {
                const LAS float* rb = rb0 + ((4 * bt + tt) >> 1) * 31 + 4 * (tt & 1);
                f32x4 a = (f32x4){rb[0], rb[1], rb[2], rb[3]};
#pragma unroll
                for (int ks = 0; ks < 4; ++ks) a = __builtin_amdgcn_mfma_f32_16x16x32_bf16(KB[bt & 1][tt * 4 + ks], Qf[ks], a, 0, 0, 0);
                st[4 * bt + tt] = a;
            }
            if (bt == 0) NA_LOADK(2);
            if (bt == 1) NA_LOADK(3);
            __builtin_amdgcn_sched_barrier(0);
        }
        bf16x8 VB[2][16];
        NA_LOADV(0); NA_LOADV(1);
        __builtin_amdgcn_sched_barrier(0);
        float mx = -1e30f;
#pragma unroll
        for (int t = 0; t < 16; ++t) {
            const int hf = t & 1;
#pragma unroll
            for (int e = 0; e < 4; ++e) {
                const int kcol = c0 + 8 * g + 4 * hf + e;
                const bool valid = (kcol >= cs) && (kcol < cs + 16);
                const float sc = valid ? st[t][e] : -1e30f;
                st[t][e] = sc; mx = fmaxf(mx, sc);
            }
        }
        mx = fmaxf(mx, shx(mx, 16, lane)); mx = fmaxf(mx, shx(mx, 32, lane));
        float sum = 0.f;
#pragma unroll
        for (int t = 0; t < 16; ++t)
#pragma unroll
            for (int e = 0; e < 4; ++e) { const float pv = fexp(st[t][e] - mx); st[t][e] = pv; sum += pv; }
        sum += shx(sum, 16, lane); sum += shx(sum, 32, lane);
        const float inv = 1.0f / sum;
        bf16x8 Pf[8];
#pragma unroll
        for (int kk = 0; kk < 8; ++kk) {
            u32x4 w; w.x = cvt_pk_bf16(st[2 * kk][0], st[2 * kk][1]); w.y = cvt_pk_bf16(st[2 * kk][2], st[2 * kk][3]);
            w.z = cvt_pk_bf16(st[2 * kk + 1][0], st[2 * kk + 1][1]); w.w = cvt_pk_bf16(st[2 * kk + 1][2], st[2 * kk + 1][3]);
            Pf[kk] = __builtin_bit_cast(bf16x8, w);
        }
        __builtin_amdgcn_sched_barrier(0);
#pragma unroll
        for (int vb = 0; vb < 4; ++vb) {
#pragma unroll
            for (int dd = 0; dd < 2; ++dd) {
                f32x4 O = (f32x4){0.f, 0.f, 0.f, 0.f};
#pragma unroll
                for (int kk = 0; kk < 8; ++kk) O = __builtin_amdgcn_mfma_f32_16x16x32_bf16(VB[vb & 1][dd * 8 + kk], Pf[kk], O, 0, 0, 0);
                u32x2 w; w.x = cvt_pk_bf16(O[0] * inv, O[1] * inv); w.y = cvt_pk_bf16(O[2] * inv, O[3] * inv);
                *(u32x2*)(ob + (size_t)tq * 1024 + hh * 128 + 16 * (2 * vb + dd) + 4 * g) = w;
            }
            if (vb == 0) NA_LOADV(2);
            if (vb == 1) NA_LOADV(3);
            __builtin_amdgcn_sched_barrier(0);
        }
#undef NA_LOADK
#undef NA_LOADV
    }
}

#define XB_TMO      128
#define XB_XCNT(j)  (256  + 64 * (j))
#define XB_XSUB(j)  (1280 + 64 * (j))
#define XB_XGEN(j)  (2304 + 64 * (j))
#define XB_TOP      3328
#define XB_TOPGEN   3392
#define XCD_BAR_WORDS 3456
#define XB_SPIN_CAP (1u << 22)
__device__ __forceinline__ unsigned xb_ld(unsigned* p)              { return __hip_atomic_load(p, __ATOMIC_RELAXED, __HIP_MEMORY_SCOPE_AGENT); }
__device__ __forceinline__ unsigned xb_add(unsigned* p, unsigned v) { return __hip_atomic_fetch_add(p, v, __ATOMIC_RELAXED, __HIP_MEMORY_SCOPE_AGENT); }
__device__ __forceinline__ unsigned xb_xcc_id() { return (unsigned)__builtin_amdgcn_s_getreg((3 << 11) | 20) & 0xFu; }
#define XB_SPIN(cond, bar) do { unsigned _sp = 0; while (cond) { __builtin_amdgcn_s_sleep(1); \
    if ((++_sp & 255u) == 0u) { if (xb_ld(&(bar)[XB_TMO])) break; if (_sp > XB_SPIN_CAP) { atomicAdd(&(bar)[XB_TMO], 1u); break; } } } } while (0)
struct XcdBarrier { unsigned* bar; unsigned x; volatile LAS unsigned* st; };
__device__ __forceinline__ XcdBarrier xcd_barrier_post(unsigned* bar, volatile LAS unsigned* st) {
    XcdBarrier b; b.bar = bar; b.x = xb_xcc_id(); b.st = st;
    if (threadIdx.x == 0) (void)xb_add(&bar[XB_XCNT(b.x)], 1u);
    return b;
}
__device__ __forceinline__ void xcd_barrier_complete(unsigned* bar, unsigned x, unsigned& nloc, unsigned& nx) {
    const unsigned G = gridDim.x * gridDim.y * gridDim.z;
    unsigned sum, cnt, mine, sp = 0u;
    for (;;) {
        sum = 0u; cnt = 0u; mine = 0u;
#pragma unroll
        for (unsigned j = 0; j < 16; ++j) { const unsigned c = xb_ld(&bar[XB_XCNT(j)]); sum += c; cnt += (c > 0u) ? 1u : 0u; mine = (j == x) ? c : mine; }
        if (sum == G) break;
        __builtin_amdgcn_s_sleep(1);
        if ((++sp & 255u) == 0u) { if (xb_ld(&bar[XB_TMO])) break; if (sp > XB_SPIN_CAP) { atomicAdd(&bar[XB_TMO], 1u); break; } }
    }
    nloc = mine > 0u ? mine : 1u; nx = cnt > 0u ? cnt : 1u;
}
__device__ __forceinline__ void xcd_barrier(const XcdBarrier& b) {
    asm volatile("s_waitcnt vmcnt(0)" ::: "memory");
    __syncthreads();
    if (threadIdx.x == 0) {
        unsigned* bar = b.bar;
        __builtin_amdgcn_s_waitcnt(0);
        unsigned nloc = b.st[0], nx = b.st[1];
        if (nloc == 0u) { xcd_barrier_complete(bar, b.x, nloc, nx); b.st[0] = nloc; b.st[1] = nx; }
        const unsigned old = xb_add(&bar[XB_XSUB(b.x)], 1u);
        const unsigned gen = old / nloc;
        if (old + 1u == (gen + 1u) * nloc) {
            __builtin_amdgcn_fence(__ATOMIC_RELEASE, "agent");
            asm volatile("s_waitcnt vmcnt(0)" ::: "memory");
            const unsigned og = xb_add(&bar[XB_TOP], 1u);
            const unsigned tg = og / nx;
            if (og + 1u == (tg + 1u) * nx) xb_add(&bar[XB_TOPGEN], 1u);
            else XB_SPIN(xb_ld(&bar[XB_TOPGEN]) == tg, bar);
            __builtin_amdgcn_fence(__ATOMIC_ACQUIRE, "agent");
            xb_add(&bar[XB_XGEN(b.x)], 1u);
            asm volatile("s_waitcnt vmcnt(0)" ::: "memory");
        } else {
            XB_SPIN(xb_ld(&bar[XB_XGEN(b.x)]) == gen, bar);
            __builtin_amdgcn_fence(__ATOMIC_ACQUIRE, "agent");
            asm volatile("s_waitcnt vmcnt(0)" ::: "memory");
        }
    }
    __syncthreads();
}

constexpr int NPH = 25, LDS_BYTES = 131072 + 16, NREC = 32;
#ifndef PHMASK
#define PHMASK 0xFFFF
#endif
#ifndef REPMASK
#define REPMASK 0
#endif
__global__ void __launch_bounds__(512, 2) mk_fwd(P p) {
    extern __shared__ __attribute__((aligned(16))) unsigned char shm[];
    LAS unsigned char* lds = (LAS unsigned char*)shm;
    volatile LAS unsigned* xbst = (volatile LAS unsigned*)(lds + 131072);
    if (threadIdx.x == 0) { xbst[0] = 0u; xbst[1] = 0u; xbst[2] = 0u; xbst[3] = 0u; }
    if (p.coop && blockIdx.x == 0) { unsigned* bw = (unsigned*)(p.ws + OFF_BAR); for (int i = threadIdx.x; i < XCD_BAR_WORDS; i += 512) bw[i] = 0u; }
    __syncthreads();
    XcdBarrier xb; xb.bar = (unsigned*)(p.ws + OFF_BAR); xb.x = 0u; xb.st = xbst;
    int rep = 0;
    for (int ph = p.ph_lo; ph < p.ph_hi;) {
        int tid = threadIdx.x, bid = blockIdx.x; unsigned long long zo = 0;
        asm volatile("" : "+v"(tid)); asm volatile("" : "+s"(bid)); asm volatile("" : "+s"(zo));
        unsigned char* ws = p.ws + zo;
        if (ph == 0) {
            {
                conv_A(p, ws, 0, lds, tid, bid);
                cvt_flat(p.x, (u16*)(ws + OFF_XB), (size_t)M_ * D_ / 4, tid, bid);
            }
        } else {
            const int l = (ph - 1) / 12, sp = (ph - 1) % 12;
            if (sp == 0 && (PHMASK & 1)) {
                Sched1 S{(const char*)(ws + OFF_XB), (const char*)(ws + OFF_WIN), 2048, 128, 32, 0, bid};
                EpiG1a E{(u16*)(ws + OFF_MIX), (u16*)(ws + OFF_VT), p.b_in + l * 12288, p.lbl, l};
                gemm_phase(lds, S, E, tid);
            } else if (sp == 1 && (PHMASK & 2)) {
                for (int item = bid; item < 256; item += (int)gridDim.x) rec1_phase(ws, lds, tid, item);
            } else if (sp == 2 && (PHMASK & 4)) {
                rec2_phase(ws, tid, bid);
                na_phase(p, ws, l, lds, 0, tid, bid);
            } else if (sp == 3 && (PHMASK & 8)) {
                rec3_phase(ws, lds, tid, bid);
            } else if (sp == 4 && (PHMASK & 16)) {
                post_phase(p, ws, l, tid, bid);
            } else if (sp == 5 && (PHMASK & 32)) {
                Sched1 S{(const char*)(ws + OFF_XB), (const char*)(ws + OFF_WIN), 2048, 128, 16, 32, bid};
                EpiG1b E{(u16*)(ws + OFF_GATES), p.b_in + l * 12288};
                gemm_phase(lds, S, E, tid);
            } else if (sp == 6 && (PHMASK & 64)) {
                Sched2 S{(const char*)(ws + OFF_OFW), (const char*)(ws + OFF_WBR), (const char*)(ws + OFF_OB), (const char*)(ws + OFF_WBR + 2048 * 1024 * 2), 1024, 1024, 128, 8, bid};
                EpiG3 E{(const u16*)(ws + OFF_GATES), (u16*)(ws + OFF_MERGED)};
                gemm_phase(lds, S, E, tid);
            } else if (sp == 7 && (PHMASK & 128)) {
                Sched1 S{(const char*)(ws + OFF_MERGED), (const char*)(ws + OFF_WOUT), 2048, 128, 8, 0, bid};
                if (l == 0) { EpiG4<0> E{p.x, p.out, (const float*)(ws + OFF_STATS), p.ln2g, p.ln2b}; gemm_phase(lds, S, E, tid); }
                else { EpiG4<1> E{p.out, p.out, (const float*)(ws + OFF_STATS), p.ln2g, p.ln2b}; gemm_phase(lds, S, E, tid); }
            } else if (sp == 8 && (PHMASK & 256)) {
                ln_phase<0>(p.out, p.ln1g + l * 2048, p.ln1b + l * 2048, (u16*)(ws + OFF_XB), (float*)(ws + OFF_STATS), tid, bid);
                __syncthreads();
                conv_B(p, ws, l, lds, tid, bid);
            } else if (sp == 9 && (PHMASK & 512)) {
                Sched1 S{(const char*)(ws + OFF_XB), (const char*)(ws + OFF_WUPG), 2048, 128, 52, 0, bid};
                EpiG6 E{(u16*)(ws + OFF_H), (u16*)(ws + OFF_SG)};
                gemm_phase(lds, S, E, tid);
            } else if (sp == 10 && (PHMASK & 1024)) {
                Sched2 S{(const char*)(ws + OFF_PB), (const char*)(ws + OFF_WPE), (const char*)(ws + OFF_H), (const char*)(ws + OFF_WDOWN), 256, FH, 128, 8, bid};
                EpiG7 E{(const u16*)(ws + OFF_SG), p.out, (const float*)(ws + OFF_STATS), p.ln1g + l * 2048, p.ln1b + l * 2048};
                gemm_phase(lds, S, E, tid);
            } else if (sp == 11 && (PHMASK & 2048)) {
                if (l == 0) ln_phase<0>(p.out, p.ln2g, p.ln2b, (u16*)(ws + OFF_XB), (float*)(ws + OFF_STATS), tid, bid);
                else ln_phase<1>(p.out, p.ln2g + 2048, p.ln2b + 2048, (u16*)(ws + OFF_XB), (float*)(ws + OFF_STATS), tid, bid);
                if (l == 0) { __syncthreads(); conv_A(p, ws, 1, lds, tid, bid); }
            }
        }
        if (REPMASK != 0 && ph > 0 && ((REPMASK >> ((ph - 1) % 12)) & 1) && rep == 0) rep = 1; else { rep = 0; ++ph; }
        if (ph < p.ph_hi) {
            if (p.coop) {
                if (ph == 1 && p.ph_lo == 0) {
                    asm volatile("s_waitcnt vmcnt(0) lgkmcnt(0)" ::: "memory");
                    cg::this_grid().sync();
                    xb = xcd_barrier_post((unsigned*)(p.ws + OFF_BAR), xbst);
                } else xcd_barrier(xb);
            }
        }
        __syncthreads();
    }
}

extern "C" void kernel_launch(void* const* d_in, const int* in_sizes, int n_in, void* d_out, int out_size, void* d_ws, size_t ws_size, hipStream_t stream) {
    static int grid = 0;
    if (grid == 0) {
        if (ws_size < WS_END) { fprintf(stderr, "kernel_launch: workspace too small: %zu < %zu\n", ws_size, (size_t)WS_END); grid = -1; return; }
        if (hipFuncSetAttribute((const void*)mk_fwd, hipFuncAttributeMaxDynamicSharedMemorySize, LDS_BYTES) != hipSuccess) { fprintf(stderr, "kernel_launch: hipFuncSetAttribute failed\n"); grid = -1; return; }
        int dev = 0, cus = 0, per_cu = 0;
        hipGetDevice(&dev);
        hipDeviceGetAttribute(&cus, hipDeviceAttributeMultiprocessorCount, dev);
        if (hipOccupancyMaxActiveBlocksPerMultiprocessor(&per_cu, (const void*)mk_fwd, 512, LDS_BYTES) != hipSuccess || per_cu < 1) { fprintf(stderr, "kernel_launch: occupancy query failed (%d)\n", per_cu); (void)hipGetLastError(); per_cu = 1; }
        grid = cus * 1;
        if (grid < 64) { fprintf(stderr, "kernel_launch: unexpected CU count %d\n", cus); grid = -1; return; }
    }
    if (grid < 0) return;
    P p{};
    p.x = (const float*)d_in[0]; p.p = (const float*)d_in[1]; p.w_in = (const float*)d_in[2]; p.b_in = (const float*)d_in[3]; p.lbl = (const float*)d_in[4];
    p.ang = (const float*)d_in[5]; p.rpb = (const float*)d_in[6]; p.w_branch = (const float*)d_in[7]; p.w_out = (const float*)d_in[8];
    p.ln1g = (const float*)d_in[9]; p.ln1b = (const float*)d_in[10]; p.w_up = (const float*)d_in[11]; p.w_down = (const float*)d_in[12];
    p.w_pe = (const float*)d_in[13]; p.w_pg = (const float*)d_in[14]; p.ln2g = (const float*)d_in[15]; p.ln2b = (const float*)d_in[16];
    p.out = (float*)d_out; p.ws = (unsigned char*)d_ws; p.coop = 0; p.pad = 0;
    p.ph_lo = 0; p.ph_hi = NPH; p.coop = 1;
    void* args[] = {&p};
    hipError_t e = hipLaunchCooperativeKernel((const void*)mk_fwd, dim3(grid), dim3(512), args, LDS_BYTES, stream);
    if (e != hipSuccess) fprintf(stderr, "kernel_launch: cooperative launch failed: %s (grid %d)\n", hipGetErrorString(e), grid);
}
```
